# Optimizing an MI355X kernel written in HIP

```python
import math
import jax, jax.numpy as jnp
from jax import lax
import numpy as np

D_MODEL = 2048
BATCH = 8
SEQ = 2048
DEPTH = 1

HEAD_DIM = 128
N_HEADS_FOX = 8
N_HEADS_DIL = 8
D_FOX = N_HEADS_FOX * HEAD_DIM
D_DIL = N_HEADS_DIL * HEAD_DIM
MIX_WIDTH = D_FOX + D_DIL
D_IN_PROJ = 3 * D_FOX + N_HEADS_FOX + 3 * D_DIL
D_FF = 256 * (-(-8 * D_MODEL // (3 * 256)))
PLE_DIM = 256
Q_BLOCK = 128
DILATED_PATTERNS = ((128, 1), (512, 4), (2048, 16))
N_REL_BUCKETS = 32
REL_MAX_DISTANCE = 2048
RMS_EPS = 1e-6
NEG_INF = -1e30

kernel_name = "hybrid_fox_dilated_macaron_block"


def rmsnorm(x, g):
    xf = x.astype(jnp.float32)
    y = xf * lax.rsqrt(jnp.mean(xf * xf, axis=-1, keepdims=True) + RMS_EPS)
    return (y * g.astype(jnp.float32)).astype(x.dtype)


def swiglu(h, w_gate, w_up, w_down):
    return (jax.nn.silu(h @ w_gate) * (h @ w_up)) @ w_down


def t5_bucket(dist):
    max_exact = N_REL_BUCKETS // 2
    d = jnp.maximum(dist, 1).astype(jnp.float32)
    large = max_exact + (jnp.log(d / max_exact) / math.log(REL_MAX_DISTANCE / max_exact)
                         * (N_REL_BUCKETS - max_exact)).astype(jnp.int32)
    large = jnp.minimum(large, N_REL_BUCKETS - 1)
    return jnp.where(dist < max_exact, dist, large)


def forgetting_attention(q, k, v, log_f):
    B, S, H, Dh = q.shape
    scale = HEAD_DIM ** -0.5
    c = jnp.cumsum(log_f, axis=1).transpose(0, 2, 1)
    outs = []
    for i in range(S // Q_BLOCK):
        t0, t1 = i * Q_BLOCK, (i + 1) * Q_BLOCK
        s = jnp.einsum('bqhd,bkhd->bhqk', q[:, t0:t1], k[:, :t1]).astype(jnp.float32) * scale
        decay = c[:, :, t0:t1, None] - c[:, :, None, :t1]
        causal = (t0 + jnp.arange(Q_BLOCK))[:, None] >= jnp.arange(t1)[None, :]
        s = jnp.where(causal, s + decay, NEG_INF)
        pr = jax.nn.softmax(s, axis=-1)
        outs.append(jnp.einsum('bhqk,bkhd->bqhd', pr.astype(v.dtype), v[:, :t1]))
    return jnp.concatenate(outs, axis=1)


def dilated_window_attention(q, k, v, rel_table, window, dilation):
    B, S, H, Dh = q.shape
    n = window // dilation
    blk = n
    L = S // dilation
    nb = -(-L // blk)
    Lp = nb * blk
    scale = HEAD_DIM ** -0.5

    def sub(a):
        return a.reshape(B, L, dilation, H, Dh).transpose(0, 2, 1, 3, 4)

    qs = jnp.pad(sub(q), ((0, 0), (0, 0), (0, Lp - L), (0, 0), (0, 0)))
    kv_pad = ((0, 0), (0, 0), (blk, Lp - L), (0, 0), (0, 0))
    ks = jnp.pad(sub(k), kv_pad)
    vs = jnp.pad(sub(v), kv_pad)

    def windows(a):
        prev = a[:, :, :Lp].reshape(B, dilation, nb, blk, H, Dh)
        cur = a[:, :, blk:].reshape(B, dilation, nb, blk, H, Dh)
        return jnp.concatenate([prev, cur], axis=3)

    qb = qs.reshape(B, dilation, nb, blk, H, Dh)
    kw, vw = windows(ks), windows(vs)

    qi = jnp.arange(blk)[:, None]
    ki = jnp.arange(2 * blk)[None, :]
    rel = qi + blk - ki
    key_sub = (jnp.arange(nb) * blk)[:, None, None] - blk + ki[None]
    valid = (rel >= 0)[None] & (rel <= n)[None] & (key_sub >= 0)
    bias = rel_table[t5_bucket(jnp.maximum(rel, 0) * dilation)].transpose(2, 0, 1)

    s = jnp.einsum('brnqhd,brnkhd->brnhqk', qb, kw).astype(jnp.float32) * scale
    s = jnp.where(valid[:, None], s + bias.astype(jnp.float32), NEG_INF)
    m = jnp.max(s, axis=-1, keepdims=True)
    e = jnp.exp(s - m)
    denom = jnp.sum(e, axis=-1, keepdims=True)
    o = jnp.einsum('brnhqk,brnkhd->brnqhd', (e / denom).astype(v.dtype), vw)
    lse = (m + jnp.log(denom))[..., 0]

    o = o.reshape(B, dilation, Lp, H, Dh)[:, :, :L].transpose(0, 2, 1, 3, 4).reshape(B, S, H, Dh)
    lse = lse.transpose(0, 1, 2, 4, 3).reshape(B, dilation, Lp, H)[:, :, :L]
    lse = lse.transpose(0, 2, 1, 3).reshape(B, S, H)
    return o, lse


def token_mixer(h, w_in, b_f, w_o, rel_table):
    B, S, _ = h.shape
    u = h @ w_in
    splits = np.cumsum([D_FOX, D_FOX, D_FOX, N_HEADS_FOX, D_DIL, D_DIL]).tolist()
    qa, ka, va, f_logit, qb, kb, vb = jnp.split(u, splits, axis=-1)
    heads = lambda a, H: a.reshape(B, S, H, HEAD_DIM)

    log_f = jax.nn.log_sigmoid((f_logit + b_f).astype(jnp.float32))
    o_a = forgetting_attention(heads(qa, N_HEADS_FOX), heads(ka, N_HEADS_FOX),
                               heads(va, N_HEADS_FOX), log_f)

    qb, kb, vb = heads(qb, N_HEADS_DIL), heads(kb, N_HEADS_DIL), heads(vb, N_HEADS_DIL)
    outs, lses = [], []
    for window, dilation in DILATED_PATTERNS:
        o_i, lse_i = dilated_window_attention(qb, kb, vb, rel_table, window, dilation)
        outs.append(o_i)
        lses.append(lse_i)
    wts = jax.nn.softmax(jnp.stack(lses, axis=0), axis=0)
    o_b = jnp.sum(wts[..., None] * jnp.stack(outs, axis=0).astype(jnp.float32), axis=0).astype(h.dtype)

    cat = jnp.concatenate([o_a.reshape(B, S, D_FOX), o_b.reshape(B, S, D_DIL)], axis=-1)
    return cat @ w_o


def setup_inputs(seed: int = 0) -> dict:
    key = jax.random.key(seed)
    ks = jax.random.split(key, 24)
    nrm = lambda k, shape, s: jax.random.normal(k, shape, jnp.float32) * s
    gain = lambda k: 1.0 + 0.05 * jax.random.normal(k, (DEPTH, D_MODEL), jnp.float32)
    return {
        "x": nrm(ks[0], (BATCH, SEQ, D_MODEL), 1.0),
        "p": nrm(ks[1], (DEPTH, BATCH, SEQ, PLE_DIM), 1.0),
        "norm_ffn1": gain(ks[2]),
        "ffn1_w_gate": nrm(ks[3], (DEPTH, D_MODEL, D_FF), D_MODEL ** -0.5),
        "ffn1_w_up": nrm(ks[4], (DEPTH, D_MODEL, D_FF), D_MODEL ** -0.5),
        "ffn1_w_down": nrm(ks[5], (DEPTH, D_FF, D_MODEL), D_FF ** -0.5),
        "norm_mix": gain(ks[6]),
        "w_in": nrm(ks[7], (DEPTH, D_MODEL, D_IN_PROJ), D_MODEL ** -0.5),
        "b_f": 2.0 + nrm(ks[8], (DEPTH, N_HEADS_FOX), 0.1),
        "w_o": nrm(ks[9], (DEPTH, MIX_WIDTH, D_MODEL), MIX_WIDTH ** -0.5),
        "norm_ffn2": gain(ks[10]),
        "ffn2_w_gate": nrm(ks[11], (DEPTH, D_MODEL, D_FF), D_MODEL ** -0.5),
        "ffn2_w_up": nrm(ks[12], (DEPTH, D_MODEL, D_FF), D_MODEL ** -0.5),
        "ffn2_w_down": nrm(ks[13], (DEPTH, D_FF, D_MODEL), D_FF ** -0.5),
        "norm_ple": gain(ks[14]),
        "w_ple_gate": nrm(ks[15], (DEPTH, D_MODEL, D_MODEL), D_MODEL ** -0.5),
        "w_ple_proj": nrm(ks[16], (DEPTH, PLE_DIM, D_MODEL), PLE_DIM ** -0.5),
        "rel_table": nrm(ks[17], (N_REL_BUCKETS, N_HEADS_DIL), 0.5),
        "norm_final": 1.0 + 0.05 * jax.random.normal(ks[18], (D_MODEL,), jnp.float32),
    }


def reference(x, p, norm_ffn1, ffn1_w_gate, ffn1_w_up, ffn1_w_down, norm_mix, w_in, b_f, w_o,
              norm_ffn2, ffn2_w_gate, ffn2_w_up, ffn2_w_down, norm_ple, w_ple_gate, w_ple_proj,
              rel_table, norm_final):
    for i in range(DEPTH):
        x = x + 0.5 * swiglu(rmsnorm(x, norm_ffn1[i]), ffn1_w_gate[i], ffn1_w_up[i], ffn1_w_down[i])
        x = x + token_mixer(rmsnorm(x, norm_mix[i]), w_in[i], b_f[i], w_o[i], rel_table)
        x = x + 0.5 * swiglu(rmsnorm(x, norm_ffn2[i]), ffn2_w_gate[i], ffn2_w_up[i], ffn2_w_down[i])
        gate = jax.nn.sigmoid(rmsnorm(x, norm_ple[i]) @ w_ple_gate[i])
        x = x + gate * (p[i] @ w_ple_proj[i])
    return rmsnorm(x, norm_final)
```

```cpp
#include <hip/hip_runtime.h>
#include <hip/hip_cooperative_groups.h>
#include <cstdio>
#include <cstdint>
namespace cg = cooperative_groups;

#define LAS __attribute__((address_space(3)))
#define GAS __attribute__((address_space(1)))
typedef unsigned short bf16_t;
typedef short bf16x8 __attribute__((ext_vector_type(8)));
typedef float f32x4 __attribute__((ext_vector_type(4)));
typedef float f32x2 __attribute__((ext_vector_type(2)));
typedef float f32x16 __attribute__((ext_vector_type(16)));
typedef unsigned u32x4 __attribute__((ext_vector_type(4)));
typedef unsigned u32x2 __attribute__((ext_vector_type(2)));
typedef __bf16 bf16x2_t __attribute__((ext_vector_type(2)));

constexpr int BATCH = 8, SEQ = 2048, DM = 2048, FF = 5632, PLE = 256, NH = 8, HD = 128;
constexpr int M = BATCH * SEQ;
constexpr int NQK = 4096;
constexpr int NVT = 2048;
constexpr int DIN = 6152;
constexpr float RMS_EPS = 1e-6f;
constexpr float LOG2E = 1.4426950408889634f;

constexpr size_t MiB = 1u << 20;
constexpr size_t WS_SS = 0;
constexpr size_t WS_BAR = 384 * 1024;
constexpr size_t WS_LOGF = 512 * 1024;
constexpr size_t WS_WF = 1 * MiB;
constexpr size_t WS_W1 = 2 * MiB;
constexpr size_t WS_WD1 = 46 * MiB;
constexpr size_t WS_VT = 2 * MiB;
constexpr size_t WS_WQK = 68 * MiB;
constexpr size_t WS_WV = 84 * MiB;
constexpr size_t WS_WO = 92 * MiB;
constexpr size_t WS_W2 = 100 * MiB;
constexpr size_t WS_WD2 = 144 * MiB;
constexpr size_t WS_WPG = 166 * MiB;
constexpr size_t WS_WPP = 174 * MiB;
constexpr size_t WS_PB = 176 * MiB;
constexpr size_t WS_XB = 184 * MiB;
constexpr size_t WS_H = 248 * MiB;
constexpr size_t WS_QK = 248 * MiB;
constexpr size_t WS_CAT = 424 * MiB;
constexpr size_t WS_END = 488 * MiB;

__device__ __forceinline__ unsigned cvtpk(float lo, float hi) { f32x2 v = {lo, hi}; bf16x2_t b = __builtin_convertvector(v, bf16x2_t); return __builtin_bit_cast(unsigned, b); }
__device__ __forceinline__ float wave_sum(float v) {
#pragma unroll
    for (int o = 1; o < 64; o <<= 1) v += __shfl_xor(v, o);
    return v;
}
__device__ __forceinline__ int opaque_tid() { int t = threadIdx.x; asm volatile("" : "+v"(t)); return t; }
__device__ __forceinline__ float rs_from_ss(float ss) { return rsqrtf(ss * (1.0f / DM) + RMS_EPS); }

#ifndef PG8_BOUSTRO
#define PG8_BOUSTRO 1
#endif
namespace pg8 {
constexpr int BM = 256, BK = 64, HALF = 128, HTB = HALF * BK * 2, STAGE_BYTES = 8 * HTB, NXCD = 8, WGM = 4;
__host__ __device__ __forceinline__ int lds_byte(int r, int c) { const int st = (r >> 4) * 2 + (c >> 5), rr = r & 15, cc = c & 31, ob = rr * 64 + cc * 2; return st * 1024 + (ob ^ (((ob >> 9) & 1) << 5)); }
__host__ __device__ __forceinline__ void stage_rc(int b, int& R, int& C) { const int st = b / 1024, sb = b % 1024, swz = sb ^ (((sb >> 9) & 1) << 5); R = (st >> 1) * 16 + swz / 64; C = (st & 1) * 32 + (swz % 64) / 2; }
__host__ __device__ __forceinline__ int perm32(int rho) { const int n = rho >> 4, i = rho & 15; return 8 * (i >> 2) + 4 * n + (i & 3); }

struct Unit { int pm, pn; };
struct Gemm { const bf16_t* A; const bf16_t* Bt; int M, N, K; };

struct StaticOrder {
    int nM, nN, nwg, G, c, wgm;
    __device__ void init(int M_, int N_, int G_, int c_, int wgm_) { nM = M_ / BM; nN = N_ / BM; nwg = nM * nN; G = G_; c = c_; wgm = wgm_; }
    __device__ bool next(int i, Unit& u) const {
        const long L = (long)i * G + c; if (L >= nwg) return false;
        int wgid = (int)L; { const int q = nwg / NXCD, r = nwg % NXCD, xcd = wgid % NXCD, off = wgid / NXCD; wgid = (xcd < r ? xcd * (q + 1) : r * (q + 1) + (xcd - r) * q) + off; }
        const int nig = wgm * nN, gid = wgid / nig, fm = gid * wgm, gsz = (nM - fm) < wgm ? (nM - fm) : wgm;
        u.pm = fm + ((wgid % nig) % gsz); u.pn = (wgid % nig) / gsz; return true;
    }
};

enum { EPI_SWIGLU = 0, EPI_RESID = 1, EPI_BF16 = 2, EPI_COLSCALE = 3, EPI_PLE = 4 };
struct Epi {
    int mode;
    bf16_t* ob; int ldc;
    const float* ss_in;
    const float* base; float* of;
    float* ss_out;
    const bf16_t* proj;
    const bf16_t* xb_in;
    float alpha;
};
__device__ __forceinline__ void unpack8(const u32x4 w, f32x4& a, f32x4& b) {
    a[0] = __uint_as_float(w.x << 16); a[1] = __uint_as_float(w.x & 0xffff0000u); a[2] = __uint_as_float(w.y << 16); a[3] = __uint_as_float(w.y & 0xffff0000u);
    b[0] = __uint_as_float(w.z << 16); b[1] = __uint_as_float(w.z & 0xffff0000u); b[2] = __uint_as_float(w.w << 16); b[3] = __uint_as_float(w.w & 0xffff0000u);
}
__device__ __forceinline__ float silu_mul(float g, float u) { return g * __builtin_amdgcn_rcpf(1.0f + __expf(-g)) * u; }
__device__ __forceinline__ float sigmoidf_(float g) { return __builtin_amdgcn_rcpf(1.0f + __expf(-g)); }

__device__ __forceinline__ void epilogue(const Epi& E, f32x4 (&acc)[2][2][4][2], const Unit& u, int wr, int wc, int fr, int fq, const LAS float* rsl) {
    const int row0 = u.pm * BM + wr * 64 + fr;
    if (E.mode == EPI_SWIGLU) {
        const int col0 = u.pn * HALF + wc * 32 + 8 * fq;
        float rr[8];
#pragma unroll
        for (int i = 0; i < 8; ++i) rr[i] = rsl[(i >> 2) * 64 + (i & 3) * 16 + fr];
#pragma unroll
        for (int ai = 0; ai < 2; ++ai)
#pragma unroll
            for (int m = 0; m < 4; ++m) {
                const int row = row0 + ai * HALF + m * 16; const float r = rr[ai * 4 + m], nr = -r * LOG2E, r2 = r * r;
                float ov[8];
#pragma unroll
                for (int n = 0; n < 2; ++n)
#pragma unroll
                    for (int e = 0; e < 4; ++e) { const float ga = acc[ai][0][m][n][e], ua = acc[ai][1][m][n][e];
                        ov[4 * n + e] = (ga * ua) * r2 * __builtin_amdgcn_rcpf(1.0f + __builtin_amdgcn_exp2f(ga * nr)); }
                u32x4 w; w.x = cvtpk(ov[0], ov[1]); w.y = cvtpk(ov[2], ov[3]); w.z = cvtpk(ov[4], ov[5]); w.w = cvtpk(ov[6], ov[7]);
                *(u32x4*)(E.ob + (size_t)row * E.ldc + col0) = w;
            }
    } else if (E.mode == EPI_RESID) {
        const int col0 = u.pn * BM + wc * 32 + 8 * fq;
        if (E.base) {
#pragma unroll
            for (int gi = 0; gi < 4; ++gi) { const int ai = gi >> 1, mh = gi & 1;
                f32x4 bb[2][2][2];
#pragma unroll
                for (int mm = 0; mm < 2; ++mm)
#pragma unroll
                    for (int bj = 0; bj < 2; ++bj) { const float* p = E.base + (size_t)(row0 + ai * HALF + (2 * mh + mm) * 16) * DM + col0 + bj * HALF; bb[mm][bj][0] = *(const f32x4*)p; bb[mm][bj][1] = *(const f32x4*)(p + 4); }
                __builtin_amdgcn_sched_barrier(0);
#pragma unroll
                for (int mm = 0; mm < 2; ++mm) { const int m = 2 * mh + mm; float sq = 0.f; const size_t off = (size_t)(row0 + ai * HALF + m * 16) * DM + col0;
#pragma unroll
                    for (int bj = 0; bj < 2; ++bj) { const f32x4 v0 = bb[mm][bj][0] + acc[ai][bj][m][0] * E.alpha, v1 = bb[mm][bj][1] + acc[ai][bj][m][1] * E.alpha;
                        u32x4 w; w.x = cvtpk(v0[0], v0[1]); w.y = cvtpk(v0[2], v0[3]); w.z = cvtpk(v1[0], v1[1]); w.w = cvtpk(v1[2], v1[3]);
                        *(u32x4*)(E.ob + off + bj * HALF) = w;
                        sq += (v0[0] * v0[0] + v0[1] * v0[1]) + (v0[2] * v0[2] + v0[3] * v0[3]) + (v1[0] * v1[0] + v1[1] * v1[1]) + (v1[2] * v1[2] + v1[3] * v1[3]); }
                    sq += __shfl_xor(sq, 16); sq += __shfl_xor(sq, 32); if (fq == 0) unsafeAtomicAdd(E.ss_out + row0 + ai * HALF + m * 16, sq); }
                __builtin_amdgcn_sched_barrier(0);
            }
        } else {
#pragma unroll
            for (int ai = 0; ai < 2; ++ai) {
                u32x4 xw[4][2];
#pragma unroll
                for (int m = 0; m < 4; ++m)
#pragma unroll
                    for (int bj = 0; bj < 2; ++bj) xw[m][bj] = *(const u32x4*)(E.xb_in + (size_t)(row0 + ai * HALF + m * 16) * DM + col0 + bj * HALF);
                __builtin_amdgcn_sched_barrier(0);
#pragma unroll
                for (int m = 0; m < 4; ++m) { float sq = 0.f; const size_t off = (size_t)(row0 + ai * HALF + m * 16) * DM + col0;
#pragma unroll
                    for (int bj = 0; bj < 2; ++bj) { f32x4 b0, b1; unpack8(xw[m][bj], b0, b1);
                        const f32x4 v0 = b0 + acc[ai][bj][m][0] * E.alpha, v1 = b1 + acc[ai][bj][m][1] * E.alpha;
                        u32x4 w; w.x = cvtpk(v0[0], v0[1]); w.y = cvtpk(v0[2], v0[3]); w.z = cvtpk(v1[0], v1[1]); w.w = cvtpk(v1[2], v1[3]);
                        *(u32x4*)(E.ob + off + bj * HALF) = w;
                        sq += (v0[0] * v0[0] + v0[1] * v0[1]) + (v0[2] * v0[2] + v0[3] * v0[3]) + (v1[0] * v1[0] + v1[1] * v1[1]) + (v1[2] * v1[2] + v1[3] * v1[3]); }
                    sq += __shfl_xor(sq, 16); sq += __shfl_xor(sq, 32); if (fq == 0) unsafeAtomicAdd(E.ss_out + row0 + ai * HALF + m * 16, sq); }
                __builtin_amdgcn_sched_barrier(0);
            }
        }
    } else if (E.mode == EPI_PLE) {
        const int col0 = u.pn * BM + wc * 32 + 8 * fq;
        float rr[8];
#pragma unroll
        for (int i = 0; i < 8; ++i) rr[i] = rsl[(i >> 2) * 64 + (i & 3) * 16 + fr];
        u32x4 xw[2][2], pw[2][2];
#pragma unroll
        for (int bj = 0; bj < 2; ++bj) { const size_t off = (size_t)row0 * DM + col0 + bj * HALF; xw[0][bj] = *(const u32x4*)(E.xb_in + off); pw[0][bj] = *(const u32x4*)(E.proj + off); }
#pragma unroll
        for (int gi = 0; gi < 8; ++gi) { const int ai = gi >> 2, m = gi & 3, par = gi & 1;
            if (gi < 7) { const int ai2 = (gi + 1) >> 2, m2 = (gi + 1) & 3;
#pragma unroll
                for (int bj = 0; bj < 2; ++bj) { const size_t off = (size_t)(row0 + ai2 * HALF + m2 * 16) * DM + col0 + bj * HALF; xw[par ^ 1][bj] = *(const u32x4*)(E.xb_in + off); pw[par ^ 1][bj] = *(const u32x4*)(E.proj + off); } }
            __builtin_amdgcn_sched_barrier(0);
            float sq = 0.f; const size_t off = (size_t)(row0 + ai * HALF + m * 16) * DM + col0; const float r = rr[gi];
#pragma unroll
            for (int bj = 0; bj < 2; ++bj) { f32x4 b0, b1, p0, p1; unpack8(xw[par][bj], b0, b1); unpack8(pw[par][bj], p0, p1);
                const f32x4 a0 = acc[ai][bj][m][0] * r, a1 = acc[ai][bj][m][1] * r; f32x4 v0, v1;
#pragma unroll
                for (int e = 0; e < 4; ++e) { v0[e] = b0[e] + sigmoidf_(a0[e]) * p0[e]; v1[e] = b1[e] + sigmoidf_(a1[e]) * p1[e]; }
                { u32x4 w; w.x = cvtpk(v0[0], v0[1]); w.y = cvtpk(v0[2], v0[3]); w.z = cvtpk(v1[0], v1[1]); w.w = cvtpk(v1[2], v1[3]); *(u32x4*)(E.ob + off + bj * HALF) = w; }
                sq += (v0[0] * v0[0] + v0[1] * v0[1]) + (v0[2] * v0[2] + v0[3] * v0[3]) + (v1[0] * v1[0] + v1[1] * v1[1]) + (v1[2] * v1[2] + v1[3] * v1[3]); }
            sq += __shfl_xor(sq, 16); sq += __shfl_xor(sq, 32); if (fq == 0) unsafeAtomicAdd(E.ss_out + row0 + ai * HALF + m * 16, sq);
            __builtin_amdgcn_sched_barrier(0);
        }
    } else {
        const int col0 = u.pn * BM + wc * 32 + 8 * fq;
        f32x4 cs[2][2]; float rr[8];
#pragma unroll
        for (int i = 0; i < 8; ++i) rr[i] = rsl[(i >> 2) * 64 + (i & 3) * 16 + fr];
#pragma unroll
        for (int bj = 0; bj < 2; ++bj)
#pragma unroll
            for (int n = 0; n < 2; ++n) {
                cs[bj][n] = (f32x4){1.f, 1.f, 1.f, 1.f};
                if (E.mode == EPI_COLSCALE) { const f32x4 t = *(const f32x4*)(E.ss_in + col0 + bj * HALF + 4 * n);
#pragma unroll
                    for (int e = 0; e < 4; ++e) cs[bj][n][e] = rs_from_ss(t[e]); }
            }
        __builtin_amdgcn_sched_barrier(0);
#pragma unroll
        for (int ai = 0; ai < 2; ++ai)
#pragma unroll
            for (int m = 0; m < 4; ++m) {
                const int row = row0 + ai * HALF + m * 16;
                const float r = (E.mode == EPI_BF16 && E.ss_in) ? rr[ai * 4 + m] : 1.f;
#pragma unroll
                for (int bj = 0; bj < 2; ++bj) {
                    const f32x4 v0 = acc[ai][bj][m][0] * cs[bj][0] * r, v1 = acc[ai][bj][m][1] * cs[bj][1] * r;
                    u32x4 w; w.x = cvtpk(v0[0], v0[1]); w.y = cvtpk(v0[2], v0[3]); w.z = cvtpk(v1[0], v1[1]); w.w = cvtpk(v1[2], v1[3]);
                    size_t doff;
                    if (E.mode == EPI_COLSCALE) { const int c = col0 + bj * HALF, bb = c >> 11, sq = c & 2047;
                        doff = ((((size_t)bb * 16 + (row >> 7)) * 32 + (sq >> 6)) * 128 + (row & 127)) * 64 + (((((sq & 63) >> 3) ^ ((row >> 1) & 7))) << 3); }
                    else if (E.ldc == 0) { const int c = col0 + bj * HALF;
                        doff = ((size_t)((row >> 11) * 32 + (c >> 7)) * SEQ + (row & 2047)) * HD + (((((c & 127) >> 3) ^ (row & 15))) << 3); }
                    else doff = (size_t)row * E.ldc + col0 + bj * HALF;
                    *(u32x4*)(E.ob + doff) = w;
                }
            }
    }
}

__device__ __forceinline__ void gemm_phase(LAS unsigned char* lds, const Gemm g, const StaticOrder& S, const Epi& E) {
    const int tid = opaque_tid(), wid = __builtin_amdgcn_readfirstlane(tid >> 6), lane = tid & 63, wr = wid >> 2, wc = wid & 3, fr = lane & 15, fq = lane >> 4;
    const int K = g.K, nt = K / BK;
    unsigned voffA[2], voffB[2];
#pragma unroll
    for (int i = 0; i < 2; ++i) { int R, C; stage_rc(tid * 16 + i * 8192, R, C); const int Rb = (R & ~31) + perm32(R & 31);
        voffA[i] = (unsigned)(R * K + C) * 2u; voffB[i] = (unsigned)(Rb * K + C) * 2u; }
    long kstep = (long)(BK * 2);
    const size_t hstep = (size_t)HALF * K * 2;
    const size_t tstep = 2 * hstep;
    const unsigned ldsw = (unsigned)wid * 1024u;
    const int aoff = lds_byte(wr * 64 + fr, fq * 8), boff = lds_byte(wc * 32 + fr, fq * 8);
#define PG8_SA(b, h) (((b) * 2 + (h)) * HTB)
#define PG8_SB(b, h) ((4 + (b) * 2 + (h)) * HTB)
#define PG8_STAGE(bufoff, gbase, voff) do { _Pragma("unroll") for (int _i = 0; _i < 2; ++_i) \
        __builtin_amdgcn_global_load_lds((const unsigned*)((const char*)(gbase) + (voff)[_i]), (LAS unsigned*)(lds + (bufoff) + ldsw + _i * 8192), 16, 0, 0); } while (0)
#define PG8_LDA(dst, b, h) do { _Pragma("unroll") for (int m = 0; m < 4; ++m) _Pragma("unroll") for (int k = 0; k < 2; ++k) dst[m][k] = *(const LAS bf16x8*)(lds + PG8_SA(b, h) + aoff + m * 2048 + k * 1024); } while (0)
#define PG8_LDB(dst, b, h) do { _Pragma("unroll") for (int n = 0; n < 2; ++n) _Pragma("unroll") for (int k = 0; k < 2; ++k) dst[n][k] = *(const LAS bf16x8*)(lds + PG8_SB(b, h) + boff + n * 2048 + k * 1024); } while (0)
#define PG8_MMA(ai, bj, At, Bt) do { __builtin_amdgcn_s_setprio(1); _Pragma("unroll") for (int m = 0; m < 4; ++m) _Pragma("unroll") for (int n = 0; n < 2; ++n) _Pragma("unroll") for (int k = 0; k < 2; ++k) \
        acc[ai][bj][m][n] = __builtin_amdgcn_mfma_f32_16x16x32_bf16(Bt[n][k], At[m][k], acc[ai][bj][m][n], 0, 0, 0); __builtin_amdgcn_s_setprio(0); } while (0)
#define PG8_WAIT_V(n) asm volatile("s_waitcnt vmcnt(" #n ")" ::: "memory")
#define PG8_WAIT_L(n) asm volatile("s_waitcnt lgkmcnt(" #n ")" ::: "memory")
#define PG8_BAR __builtin_amdgcn_s_barrier()
#define PG8_SCHED __builtin_amdgcn_sched_barrier(0)
    Unit cur, nxt; int ui = 0;
    if (!S.next(0, cur)) return;
    f32x4 acc[2][2][4][2];
#pragma unroll
    for (int a = 0; a < 2; ++a)
#pragma unroll
        for (int b = 0; b < 2; ++b)
#pragma unroll
            for (int m = 0; m < 4; ++m)
#pragma unroll
                for (int n = 0; n < 2; ++n) acc[a][b][m][n] = (f32x4){0.f, 0.f, 0.f, 0.f};
    bf16x8 At[4][2], B0[2][2], B1[2][2];
    const long klast = (long)(nt - 1) * (BK * 2);
    const char* cA = (const char*)g.A + (size_t)cur.pm * tstep; const char* cB = (const char*)g.Bt + (size_t)cur.pn * tstep;
    const bool rowss = (E.ss_in != nullptr) && (E.mode != EPI_COLSCALE);
    LAS float* rsl = (LAS float*)(lds + STAGE_BYTES + wid * 512);
    int cached_pm = cur.pm; float ssA = 0.f, ssB = 0.f;
    if (rowss) { const float* sp = E.ss_in + cur.pm * BM + wr * 64 + lane; ssA = sp[0]; ssB = sp[HALF]; }
    PG8_STAGE(PG8_SB(0, 0), cB, voffB); PG8_STAGE(PG8_SB(0, 1), cB + hstep, voffB); PG8_STAGE(PG8_SA(0, 0), cA, voffA); PG8_STAGE(PG8_SA(0, 1), cA + hstep, voffA);
    if (wr == 1) PG8_BAR;
    PG8_WAIT_V(2); PG8_BAR;
    PG8_STAGE(PG8_SB(1, 0), cB + kstep, voffB); PG8_STAGE(PG8_SA(1, 0), cA + kstep, voffA); PG8_STAGE(PG8_SB(1, 1), cB + hstep + kstep, voffB);
    PG8_WAIT_V(6); PG8_BAR;
    if (rowss) { rsl[lane] = rs_from_ss(ssA); rsl[64 + lane] = rs_from_ss(ssB); }
    for (;;) {
        const bool has_next = S.next(ui + 1, nxt);
        const bool nrev = has_next && PG8_BOUSTRO && (((ui + 1) & 1) != 0);
        const long nkstep = has_next ? (nrev ? -(long)(BK * 2) : (long)(BK * 2)) : kstep;
        const char* nA = has_next ? (const char*)g.A + (size_t)nxt.pm * tstep + (nrev ? klast : 0) : cA; const char* nB = has_next ? (const char*)g.Bt + (size_t)nxt.pn * tstep + (nrev ? klast : 0) : cB;
        for (int t = 0; t < nt; t += 2) {
            const bool last = (t == nt - 2);
            const char* a1 = cA + (long)(t + 1) * kstep;
            const char* a2 = last ? nA : cA + (long)(t + 2) * kstep; const char* b2 = last ? nB : cB + (long)(t + 2) * kstep;
            const char* a3 = a2 + (last ? nkstep : kstep); const char* b3 = b2 + (last ? nkstep : kstep);
            PG8_LDB(B0, 0, 0); PG8_LDB(B1, 0, 1); PG8_SCHED; PG8_LDA(At, 0, 0); PG8_STAGE(PG8_SA(1, 1), a1 + hstep, voffA);
            PG8_WAIT_V(8); PG8_WAIT_L(0); PG8_BAR; PG8_MMA(0, 0, At, B0); PG8_MMA(0, 1, At, B1); PG8_BAR; PG8_SCHED;
            PG8_LDA(At, 0, 1); PG8_STAGE(PG8_SB(0, 0), b2, voffB); PG8_STAGE(PG8_SB(0, 1), b2 + hstep, voffB); PG8_STAGE(PG8_SA(0, 0), a2, voffA);
            PG8_WAIT_V(8); PG8_WAIT_L(0); PG8_BAR; PG8_MMA(1, 0, At, B0); PG8_MMA(1, 1, At, B1); PG8_BAR; PG8_SCHED;
            PG8_LDB(B0, 1, 0); PG8_LDB(B1, 1, 1); PG8_SCHED; PG8_LDA(At, 1, 0); PG8_STAGE(PG8_SA(0, 1), a2 + hstep, voffA);
            PG8_WAIT_V(8); PG8_WAIT_L(0); PG8_BAR; PG8_MMA(0, 0, At, B0); PG8_MMA(0, 1, At, B1); PG8_BAR; PG8_SCHED;
            PG8_LDA(At, 1, 1); PG8_STAGE(PG8_SB(1, 0), b3, voffB); PG8_STAGE(PG8_SB(1, 1), b3 + hstep, voffB); PG8_STAGE(PG8_SA(1, 0), a3, voffA);
            PG8_WAIT_V(8); PG8_WAIT_L(0); PG8_BAR; PG8_MMA(1, 0, At, B0); PG8_MMA(1, 1, At, B1); PG8_BAR; PG8_SCHED;
        }
        if (wr == 0) PG8_BAR;
        epilogue(E, acc, cur, wr, wc, fr, fq, rsl);
        if (!has_next) break;
#pragma unroll
        for (int a = 0; a < 2; ++a)
#pragma unroll
            for (int b = 0; b < 2; ++b)
#pragma unroll
                for (int m = 0; m < 4; ++m)
#pragma unroll
                    for (int n = 0; n < 2; ++n) acc[a][b][m][n] = (f32x4){0.f, 0.f, 0.f, 0.f};
        cur = nxt; cA = nA; cB = nB; kstep = nkstep; ++ui;
        if (rowss && cur.pm != cached_pm) { const float* sp = E.ss_in + cur.pm * BM + wr * 64 + lane; const float a_ = sp[0], b_ = sp[HALF]; rsl[lane] = rs_from_ss(a_); rsl[64 + lane] = rs_from_ss(b_); cached_pm = cur.pm; }
        if (wr == 1) PG8_BAR;
    }
    PG8_WAIT_V(0);
    PG8_BAR;
#undef PG8_SA
#undef PG8_SB
#undef PG8_STAGE
#undef PG8_LDA
#undef PG8_LDB
#undef PG8_MMA
#undef PG8_WAIT_V
#undef PG8_WAIT_L
#undef PG8_BAR
#undef PG8_SCHED
}
}

namespace att {
constexpr int KBUF = 16384, VBUF = 16384, NSLOT = 3;
constexpr int OFF_K = 0, OFF_V = NSLOT * KBUF, OFF_TAB = OFF_V + NSLOT * VBUF, TAB_N = 2048 + 64, OFF_SCAN = OFF_TAB + TAB_N * 4, LDS_BYTES = OFF_SCAN + 64;
constexpr float NEG_INF = -__builtin_inff();

__device__ __forceinline__ int pi32(int rho) { return (rho & 0x13) | ((rho & 4) << 1) | ((rho & 8) >> 1); }

__device__ __forceinline__ void build_table(LAS unsigned char* lds, int b, int hh, const float* lgf, const float* rel_table) {
    LAS float* tab = (LAS float*)(lds + OFF_TAB); LAS float* scan = (LAS float*)(lds + OFF_SCAN);
    const int tid = opaque_tid(), lane = tid & 63, wid = tid >> 6;
    if (hh < NH) {
        f32x4 a = ((const f32x4*)(lgf + (size_t)(b * NH + hh) * SEQ))[tid];
        a[1] += a[0]; a[2] += a[1]; a[3] += a[2];
        float v = a[3];
#pragma unroll
        for (int o = 1; o < 64; o <<= 1) { const float t = __shfl_up(v, o); if (lane >= o) v += t; }
        if (lane == 63) scan[wid] = v;
        __syncthreads();
        float pre = v - a[3];
        for (int w = 0; w < wid; ++w) pre += scan[w];
#pragma unroll
        for (int e = 0; e < 4; ++e) tab[4 * tid + e] = -(a[e] + pre) * LOG2E;
    } else {
        const int h = hh - NH;
        for (int x = tid; x < TAB_N; x += 512) {
            const int dl = 2047 - x; float v = NEG_INF;
            if (dl >= 0) {
                const int mult = (dl <= 128 ? 1 : 0) + (((dl & 3) == 0 && dl <= 512) ? 1 : 0) + (((dl & 15) == 0) ? 1 : 0);
                if (mult > 0) {
                    int bucket = dl;
                    if (dl >= 16) { const float d = (float)dl; int lg = 16 + (int)(logf(d / 16.0f) / 4.852030263919617f * 16.0f); bucket = lg < 31 ? lg : 31; }
                    v = (rel_table[bucket * NH + h] + logf((float)mult)) * LOG2E;
                }
            }
            tab[x] = v;
        }
    }
    __syncthreads();
}

__device__ __forceinline__ void attn_unit(LAS unsigned char* lds, int b, int hh, int qb, const bf16_t* QK, const bf16_t* VT, bf16_t* CAT) {
    const int tid = opaque_tid(), lane = tid & 63, r32 = lane & 31, hi = lane >> 5; const int wid = __builtin_amdgcn_readfirstlane(tid >> 6);
    const bool fox = hh < NH;
    const bool lead = wid < 4;
    const int qch = fox ? hh : hh + 8, kch = qch + 8;
    const int q0 = qb * 256 + wid * 32, qpos = q0 + r32;
    const LAS float* tab = (const LAS float*)(lds + OFF_TAB);
    const float C = 0.08838834764831845f * LOG2E;
    const int nt = (qb + 1) * 4;
    const char* Kg = (const char*)(QK + (size_t)(b * 32 + kch) * SEQ * HD) + wid * 2048 + lane * 16;
    const char* Vg = (const char*)(VT + (size_t)(b * 16 + hh) * SEQ * HD) + wid * 2048 + lane * 16;
#define ATT_DMAK(t) do { const int sl_ = (t) % NSLOT; _Pragma("unroll") for (int i = 0; i < 2; ++i) \
        __builtin_amdgcn_global_load_lds((const unsigned*)(Kg + (size_t)(t) * 16384 + i * 1024), (LAS unsigned*)(lds + OFF_K + sl_ * KBUF + wid * 2048 + i * 1024), 16, 0, 0); } while (0)
#define ATT_DMAV(t) do { const int sl_ = (t) % NSLOT; _Pragma("unroll") for (int i = 0; i < 2; ++i) \
        __builtin_amdgcn_global_load_lds((const unsigned*)(Vg + (size_t)(t) * 16384 + i * 1024), (LAS unsigned*)(lds + OFF_V + sl_ * VBUF + wid * 2048 + i * 1024), 16, 0, 0); } while (0)
    ATT_DMAK(0); ATT_DMAK(1); ATT_DMAV(0);
    bf16x8 qf[8];
    { const bf16_t* Qp = QK + ((size_t)(b * 32 + qch) * SEQ + qpos) * HD;
#pragma unroll
      for (int d0 = 0; d0 < 8; ++d0) qf[d0] = *(const bf16x8*)(Qp + (((2 * d0 + hi) ^ (qpos & 15)) << 3)); }
    const int krow = pi32(r32);
    int koff[8];
#pragma unroll
    for (int d0 = 0; d0 < 8; ++d0) koff[d0] = krow * 256 + (((2 * d0 + hi) ^ (krow & 15)) << 4);
    int voff[4];
#pragma unroll
    for (int c = 0; c < 4; ++c) voff[c] = r32 * 128 + (((2 * c + hi) ^ ((r32 >> 1) & 7)) << 4);
    f32x16 o[4];
#pragma unroll
    for (int d = 0; d < 4; ++d)
#pragma unroll
        for (int i = 0; i < 16; ++i) o[d][i] = 0.f;
    float mrun = -1e30f, lrun = 0.f;
    f32x16 s0, s1;
    bf16x8 pf[4];
    bool v0 = false, v1 = false, pv0 = false, pv1 = false;
#pragma unroll
    for (int i = 0; i < 16; ++i) { s0[i] = 0.f; s1[i] = 0.f; }
#pragma unroll
    for (int i = 0; i < 4; ++i) pf[i] = (bf16x8){0, 0, 0, 0, 0, 0, 0, 0};

#define ATT_QK(t_) do { const int kb0_ = (t_) * 64; v0 = (kb0_ <= q0 + 31); v1 = (kb0_ + 32 <= q0 + 31); \
        const LAS unsigned char* kp = lds + OFF_K + ((t_) % NSLOT) * KBUF; \
        if (v0) { _Pragma("unroll") for (int i = 0; i < 16; ++i) s0[i] = 0.f; bf16x8 kf[8]; \
            _Pragma("unroll") for (int d0 = 0; d0 < 8; ++d0) kf[d0] = *(const LAS bf16x8*)(kp + koff[d0]); \
            __builtin_amdgcn_sched_barrier(0); \
            _Pragma("unroll") for (int d0 = 0; d0 < 8; ++d0) s0 = __builtin_amdgcn_mfma_f32_32x32x16_bf16(kf[d0], qf[d0], s0, 0, 0, 0); \
            __builtin_amdgcn_sched_barrier(0); } \
        if (v1) { _Pragma("unroll") for (int i = 0; i < 16; ++i) s1[i] = 0.f; bf16x8 kf[8]; \
            _Pragma("unroll") for (int d0 = 0; d0 < 8; ++d0) kf[d0] = *(const LAS bf16x8*)(kp + 8192 + koff[d0]); \
            __builtin_amdgcn_sched_barrier(0); \
            _Pragma("unroll") for (int d0 = 0; d0 < 8; ++d0) s1 = __builtin_amdgcn_mfma_f32_32x32x16_bf16(kf[d0], qf[d0], s1, 0, 0, 0); \
            __builtin_amdgcn_sched_barrier(0); } \
    } while (0)

#define ATT_BIAS(SV, kbase_) do { \
        if (fox) { \
            if ((kbase_) + 31 > q0) { \
                _Pragma("unroll") for (int s = 0; s < 2; ++s) { const int kb = (kbase_) + 16 * s + 8 * hi; \
                    const f32x4 c0 = *(const LAS f32x4*)(tab + kb), c1 = *(const LAS f32x4*)(tab + kb + 4); \
                    _Pragma("unroll") for (int j = 0; j < 8; ++j) { const float ck = j < 4 ? c0[j & 3] : c1[j & 3]; float v = __builtin_fmaf(SV[8 * s + j], C, ck); \
                        if (kb + j > qpos) v = NEG_INF; SV[8 * s + j] = v; } } \
            } else { \
                _Pragma("unroll") for (int s = 0; s < 2; ++s) { const int kb = (kbase_) + 16 * s + 8 * hi; \
                    const f32x4 c0 = *(const LAS f32x4*)(tab + kb), c1 = *(const LAS f32x4*)(tab + kb + 4); \
                    _Pragma("unroll") for (int j = 0; j < 8; ++j) { const float ck = j < 4 ? c0[j & 3] : c1[j & 3]; SV[8 * s + j] = __builtin_fmaf(SV[8 * s + j], C, ck); } } \
            } \
        } else { \
            _Pragma("unroll") for (int s = 0; s < 2; ++s) { const int ix = 2047 - qpos + (kbase_) + 16 * s + 8 * hi; \
                _Pragma("unroll") for (int j = 0; j < 8; ++j) SV[8 * s + j] = __builtin_fmaf(SV[8 * s + j], C, tab[ix + j]); } } \
    } while (0)

#define ATT_PACK(dst, SV, s_) do { u32x4 w_; w_.x = cvtpk(SV[8 * (s_)], SV[8 * (s_) + 1]); w_.y = cvtpk(SV[8 * (s_) + 2], SV[8 * (s_) + 3]); \
        w_.z = cvtpk(SV[8 * (s_) + 4], SV[8 * (s_) + 5]); w_.w = cvtpk(SV[8 * (s_) + 6], SV[8 * (s_) + 7]); dst = __builtin_bit_cast(bf16x8, w_); } while (0)

#define ATT_SOFTMAX(ts_) do { pv0 = v0; pv1 = v1; \
        if (v0) { ATT_BIAS(s0, (ts_) * 64); float mx = s0[0]; \
            _Pragma("unroll") for (int i = 1; i < 16; ++i) mx = fmaxf(mx, s0[i]); \
            if (v1) { ATT_BIAS(s1, (ts_) * 64 + 32); _Pragma("unroll") for (int i = 0; i < 16; ++i) mx = fmaxf(mx, s1[i]); } \
            mx = fmaxf(mx, __shfl_xor(mx, 32)); \
            const float mnew = fmaxf(mrun, mx), alpha = __builtin_amdgcn_exp2f(mrun - mnew); mrun = mnew; \
            float rsum = 0.f; \
            _Pragma("unroll") for (int i = 0; i < 16; ++i) { s0[i] = __builtin_amdgcn_exp2f(s0[i] - mnew); rsum += s0[i]; } \
            if (v1) { _Pragma("unroll") for (int i = 0; i < 16; ++i) { s1[i] = __builtin_amdgcn_exp2f(s1[i] - mnew); rsum += s1[i]; } } \
            lrun = lrun * alpha + rsum; \
            if (__any(alpha != 1.0f)) { _Pragma("unroll") for (int d = 0; d < 4; ++d) _Pragma("unroll") for (int i = 0; i < 16; ++i) o[d][i] *= alpha; } \
            ATT_PACK(pf[0], s0, 0); ATT_PACK(pf[1], s0, 1); \
            if (v1) { ATT_PACK(pf[2], s1, 0); ATT_PACK(pf[3], s1, 1); } \
        } } while (0)

#define ATT_PV(tp_) do { const LAS unsigned char* vp = lds + OFF_V + ((tp_) % NSLOT) * VBUF; \
        if (pv0) { bf16x8 vf[8]; \
            _Pragma("unroll") for (int d = 0; d < 4; ++d) _Pragma("unroll") for (int s = 0; s < 2; ++s) vf[2 * d + s] = *(const LAS bf16x8*)(vp + d * 4096 + voff[s]); \
            __builtin_amdgcn_sched_barrier(0); \
            _Pragma("unroll") for (int d = 0; d < 4; ++d) _Pragma("unroll") for (int s = 0; s < 2; ++s) o[d] = __builtin_amdgcn_mfma_f32_32x32x16_bf16(vf[2 * d + s], pf[s], o[d], 0, 0, 0); \
            __builtin_amdgcn_sched_barrier(0); } \
        if (pv1) { bf16x8 vf[8]; \
            _Pragma("unroll") for (int d = 0; d < 4; ++d) _Pragma("unroll") for (int s = 0; s < 2; ++s) vf[2 * d + s] = *(const LAS bf16x8*)(vp + d * 4096 + voff[2 + s]); \
            __builtin_amdgcn_sched_barrier(0); \
            _Pragma("unroll") for (int d = 0; d < 4; ++d) _Pragma("unroll") for (int s = 0; s < 2; ++s) o[d] = __builtin_amdgcn_mfma_f32_32x32x16_bf16(vf[2 * d + s], pf[2 + s], o[d], 0, 0, 0); \
            __builtin_amdgcn_sched_barrier(0); } \
    } while (0)

    asm volatile("s_waitcnt vmcnt(0) lgkmcnt(0)" ::: "memory"); __builtin_amdgcn_s_barrier(); asm volatile("" ::: "memory");
    for (int t = 0; t <= nt; ++t) {
        if (t + 2 < nt) ATT_DMAK(t + 2);
        if (t + 1 < nt) ATT_DMAV(t + 1);
        if (!lead && t >= 1) ATT_SOFTMAX(t - 1);
        if (t >= 1) ATT_PV(t - 1);
        if (t < nt) ATT_QK(t);
        if (lead && t < nt) ATT_SOFTMAX(t);
        if (t + 2 < nt) asm volatile("s_waitcnt vmcnt(4) lgkmcnt(0)" ::: "memory"); else asm volatile("s_waitcnt vmcnt(0) lgkmcnt(0)" ::: "memory");
        __builtin_amdgcn_s_barrier(); asm volatile("" ::: "memory");
    }
#undef ATT_DMAK
#undef ATT_DMAV
#undef ATT_QK
#undef ATT_BIAS
#undef ATT_PACK
#undef ATT_SOFTMAX
#undef ATT_PV
    lrun += __shfl_xor(lrun, 32);
    const float inv = 1.0f / lrun;
    bf16_t* Op = CAT + (size_t)(b * SEQ + qpos) * DM + hh * HD + 4 * hi;
#pragma unroll
    for (int d = 0; d < 4; ++d)
#pragma unroll
        for (int g = 0; g < 4; ++g) { u32x2 w; w.x = cvtpk(o[d][4 * g] * inv, o[d][4 * g + 1] * inv); w.y = cvtpk(o[d][4 * g + 2] * inv, o[d][4 * g + 3] * inv);
            *(u32x2*)(Op + 32 * d + 8 * g) = w; }
}
}


#define XB_TMO      128
#define XB_XCNT(j)  (256  + 64 * (j))
#define XB_XSUB(j)  (1280 + 64 * (j))
#define XB_XGEN(j)  (2304 + 64 * (j))
#define XB_TOP      3328
#define XB_TOPGEN   3392
#define XCD_BAR_WORDS 3456
#define XB_SPIN_CAP (1u << 18)
__device__ __forceinline__ unsigned xb_ld(unsigned* p)              { return __hip_atomic_load(p, __ATOMIC_RELAXED, __HIP_MEMORY_SCOPE_AGENT); }
__device__ __forceinline__ unsigned xb_add(unsigned* p, unsigned v) { return __hip_atomic_fetch_add(p, v, __ATOMIC_RELAXED, __HIP_MEMORY_SCOPE_AGENT); }
__device__ __forceinline__ unsigned xb_xcc_id() { return (unsigned)__builtin_amdgcn_s_getreg((3 << 11) | 20) & 0xFu; }
#define XB_SPIN(cond, bar) do { unsigned _sp = 0; while (cond) { __builtin_amdgcn_s_sleep(1); \
    if ((++_sp & 255u) == 0u) { if (xb_ld(&(bar)[XB_TMO])) break; if (_sp > XB_SPIN_CAP) { atomicAdd(&(bar)[XB_TMO], 1u); break; } } } } while (0)
struct XcdBarrier { unsigned* bar; unsigned x; volatile LAS unsigned* st; };
__device__ __forceinline__ XcdBarrier xcd_barrier_post(unsigned* bar, volatile LAS unsigned* st) {
    XcdBarrier b; b.bar = bar; b.x = xb_xcc_id(); b.st = st;
    if (threadIdx.x == 0) st[5] = xb_add(&bar[XB_XCNT(b.x)], 1u);
    return b;
}
__device__ __forceinline__ void xcd_barrier_complete(unsigned* bar, unsigned x, unsigned& nloc, unsigned& nx) {
    const unsigned G = gridDim.x * gridDim.y * gridDim.z;
    unsigned sum, cnt, mine, sp = 0u;
    for (;;) {
        sum = 0u; cnt = 0u; mine = 0u;
#pragma unroll
        for (unsigned j = 0; j < 16; ++j) { const unsigned c = xb_ld(&bar[XB_XCNT(j)]); sum += c; cnt += (c > 0u) ? 1u : 0u; mine = (j == x) ? c : mine; }
        if (sum == G) break;
        __builtin_amdgcn_s_sleep(1);
        if ((++sp & 255u) == 0u) { if (xb_ld(&bar[XB_TMO])) break; if (sp > XB_SPIN_CAP) { atomicAdd(&bar[XB_TMO], 1u); break; } }
    }
    nloc = mine > 0u ? mine : 1u; nx = cnt > 0u ? cnt : 1u;
}
__device__ __forceinline__ void xcd_barrier(const XcdBarrier& b) {
    asm volatile("s_waitcnt vmcnt(0)" ::: "memory");
    __syncthreads();
    if (threadIdx.x == 0) {
        unsigned* bar = b.bar;
        __builtin_amdgcn_s_waitcnt(0);
        unsigned nloc = b.st[0], nx = b.st[1];
        if (nloc == 0u) { xcd_barrier_complete(bar, b.x, nloc, nx); b.st[0] = nloc; b.st[1] = nx; }
        const unsigned old = xb_add(&bar[XB_XSUB(b.x)], 1u);
        const unsigned gen = old / nloc;
        if (old + 1u == (gen + 1u) * nloc) {
            __builtin_amdgcn_fence(__ATOMIC_RELEASE, "agent");
            asm volatile("s_waitcnt vmcnt(0)" ::: "memory");
            const unsigned og = xb_add(&bar[XB_TOP], 1u);
            const unsigned tg = og / nx;
            if (og + 1u == (tg + 1u) * nx) xb_add(&bar[XB_TOPGEN], 1u);
            else XB_SPIN(xb_ld(&bar[XB_TOPGEN]) == tg, bar);
            __builtin_amdgcn_fence(__ATOMIC_ACQUIRE, "agent");
            xb_add(&bar[XB_XGEN(b.x)], 1u);
            asm volatile("s_waitcnt vmcnt(0)" ::: "memory");
        } else {
            XB_SPIN(xb_ld(&bar[XB_XGEN(b.x)]) == gen, bar);
            __builtin_amdgcn_fence(__ATOMIC_ACQUIRE, "agent");
            asm volatile("s_waitcnt vmcnt(0)" ::: "memory");
        }
    }
    __syncthreads();
}

constexpr int NWAVES = 8;
constexpr int LDS_BYTES = 147456;

struct Args { const float* in[19]; float* out; unsigned char* ws; };

__device__ __forceinline__ void p0_item(const float* W, int ldw, int col0, int k0, const float* gain, bf16_t* WT, int K, int drow0, LAS float* scr, int lane) {
    float v[64];
    const float* src = W + (size_t)k0 * ldw + col0 + lane;
#pragma unroll
    for (int i = 0; i < 64; ++i) v[i] = src[(size_t)i * ldw];
    const int c = lane & 7;
    f32x4 g0 = {1.f, 1.f, 1.f, 1.f}, g1 = {1.f, 1.f, 1.f, 1.f};
    if (gain) { g0 = *(const f32x4*)(gain + k0 + 8 * c); g1 = *(const f32x4*)(gain + k0 + 8 * c + 4); }
#pragma unroll
    for (int i = 0; i < 64; ++i) scr[i * 65 + lane] = v[i];
    asm volatile("s_waitcnt lgkmcnt(0)" ::: "memory");
#pragma unroll
    for (int j = 0; j < 8; ++j) { const int n = (lane >> 3) + 8 * j; const LAS float* s = scr + (8 * c) * 65 + n;
        u32x4 o; o.x = cvtpk(s[0 * 65] * g0[0], s[1 * 65] * g0[1]); o.y = cvtpk(s[2 * 65] * g0[2], s[3 * 65] * g0[3]); o.z = cvtpk(s[4 * 65] * g1[0], s[5 * 65] * g1[1]); o.w = cvtpk(s[6 * 65] * g1[2], s[7 * 65] * g1[3]);
        *(u32x4*)(WT + (size_t)(drow0 + n) * K + k0 + 8 * c) = o; }
    asm volatile("s_waitcnt lgkmcnt(0)" ::: "memory");
}

__global__ void __launch_bounds__(NWAVES * 64, 2) fwd_megakernel(Args args) {
    extern __shared__ __attribute__((aligned(16))) unsigned char lds_raw[];
    LAS unsigned char* lds = (LAS unsigned char*)lds_raw;
    cg::grid_group grid = cg::this_grid();
    const int tid = threadIdx.x, lane = tid & 63, wave = __builtin_amdgcn_readfirstlane(tid >> 6);
    const int G = gridDim.x, bx = blockIdx.x;
    const int vcu = (G % 8 == 0) ? (bx % 8) * (G / 8) + bx / 8 : bx;
    const int gw = vcu * NWAVES + wave, NGW = G * NWAVES;
    const long gt = (long)bx * (NWAVES * 64) + tid, NGT = (long)G * NWAVES * 64;
    unsigned char* ws = args.ws;
    volatile LAS unsigned* bst = (volatile LAS unsigned*)(lds + LDS_BYTES - 64);
    if (tid < 16) bst[tid] = 0u;
    if (bx == 0) for (int i = tid; i < 4096; i += NWAVES * 64) ((unsigned*)(ws + WS_BAR))[i] = 0u;
    __syncthreads();
    grid.sync();
    const XcdBarrier xbar = xcd_barrier_post((unsigned*)(ws + WS_BAR), bst);
    const float* x = args.in[0];
    float* out = args.out;
    float* ss = (float*)(ws + WS_SS);
    float* logfb = (float*)(ws + WS_LOGF);
    float* wf = (float*)(ws + WS_WF);
    bf16_t* W1 = (bf16_t*)(ws + WS_W1); bf16_t* WD1 = (bf16_t*)(ws + WS_WD1); bf16_t* VT = (bf16_t*)(ws + WS_VT);
    bf16_t* WQK = (bf16_t*)(ws + WS_WQK); bf16_t* WV = (bf16_t*)(ws + WS_WV); bf16_t* WO = (bf16_t*)(ws + WS_WO);
    bf16_t* W2 = (bf16_t*)(ws + WS_W2); bf16_t* WD2 = (bf16_t*)(ws + WS_WD2); bf16_t* WPG = (bf16_t*)(ws + WS_WPG); bf16_t* WPP = (bf16_t*)(ws + WS_WPP);
    bf16_t* PB = (bf16_t*)(ws + WS_PB); bf16_t* XB = (bf16_t*)(ws + WS_XB); bf16_t* HB = (bf16_t*)(ws + WS_H); bf16_t* QKB = (bf16_t*)(ws + WS_QK); bf16_t* CAT = (bf16_t*)(ws + WS_CAT);

    {
        LAS float* scr = (LAS float*)(lds + wave * 16640);
        constexpr int I_GU = (DM / 64) * (FF / 64), I_DN = (FF / 64) * (DM / 64), I_IN = (DM / 64) * (1024 / 64), I_SQ = (DM / 64) * (DM / 64), I_PP = (PLE / 64) * (DM / 64);
        constexpr int NITEMS = 4 * I_GU + 2 * I_DN + 6 * I_IN + 2 * I_SQ + I_PP;
        for (int it = gw; it < NITEMS; it += NGW) {
            int r = it;
#define SEG_GU(Wsrc, gainp, dst, half) if (r < I_GU) { const int nblk = FF / 64, kb = r / nblk, nb = r % nblk, n0 = 64 * nb; \
                p0_item(Wsrc, FF, n0, 64 * kb, gainp, dst, DM, (n0 / 128) * 256 + (n0 % 128) + (half) * 128, scr, lane); continue; } r -= I_GU;
#define SEG_ID(Wsrc, ldw, colbase, Kdim, ncols, gainp, dst, drow, cnt) if (r < (cnt)) { const int nblk = (ncols) / 64, kb = r / nblk, nb = r % nblk; \
                p0_item(Wsrc, ldw, (colbase) + 64 * nb, 64 * kb, gainp, dst, Kdim, (drow) + 64 * nb, scr, lane); continue; } r -= (cnt);
            SEG_GU(args.in[3], args.in[2], W1, 0)
            SEG_GU(args.in[4], args.in[2], W1, 1)
            SEG_ID(args.in[5], DM, 0, FF, DM, (const float*)nullptr, WD1, 0, I_DN)
            SEG_ID(args.in[7], DIN, 0, DM, 1024, args.in[6], WQK, 0, I_IN)
            SEG_ID(args.in[7], DIN, 1024, DM, 1024, args.in[6], WQK, 1024, I_IN)
            SEG_ID(args.in[7], DIN, 2048, DM, 1024, args.in[6], WV, 0, I_IN)
            SEG_ID(args.in[7], DIN, 3080, DM, 1024, args.in[6], WQK, 2048, I_IN)
            SEG_ID(args.in[7], DIN, 4104, DM, 1024, args.in[6], WQK, 3072, I_IN)
            SEG_ID(args.in[7], DIN, 5128, DM, 1024, args.in[6], WV, 1024, I_IN)
            SEG_ID(args.in[9], DM, 0, DM, DM, (const float*)nullptr, WO, 0, I_SQ)
            SEG_GU(args.in[11], args.in[10], W2, 0)
            SEG_GU(args.in[12], args.in[10], W2, 1)
            SEG_ID(args.in[13], DM, 0, FF, DM, (const float*)nullptr, WD2, 0, I_DN)
            SEG_ID(args.in[15], DM, 0, DM, DM, args.in[14], WPG, 0, I_SQ)
            SEG_ID(args.in[16], DM, 0, PLE, DM, (const float*)nullptr, WPP, 0, I_PP)
#undef SEG_GU
#undef SEG_ID
        }
        for (int m0 = gw * 2; m0 < M; m0 += NGW * 2) {
            f32x4 v[2][8];
#pragma unroll
            for (int q = 0; q < 2; ++q) { const f32x4* xr = (const f32x4*)(x + (size_t)(m0 + q) * DM) + lane;
#pragma unroll
                for (int j = 0; j < 8; ++j) v[q][j] = xr[64 * j]; }
#pragma unroll
            for (int q = 0; q < 2; ++q) { float sq = 0.f;
#pragma unroll
                for (int j = 0; j < 8; ++j) sq += (v[q][j][0] * v[q][j][0] + v[q][j][1] * v[q][j][1]) + (v[q][j][2] * v[q][j][2] + v[q][j][3] * v[q][j][3]);
                sq = wave_sum(sq); if (lane == 0) ss[m0 + q] = sq;
                u32x2* o8 = (u32x2*)(XB + (size_t)(m0 + q) * DM) + lane;
#pragma unroll
                for (int j = 0; j < 8; ++j) { u32x2 w; w.x = cvtpk(v[q][j][0], v[q][j][1]); w.y = cvtpk(v[q][j][2], v[q][j][3]); o8[64 * j] = w; } }
        }
        { const f32x4* p4 = (const f32x4*)args.in[1]; u32x2* o8 = (u32x2*)PB;
          for (long i = gt; i < (long)M * PLE / 4; i += 4 * NGT) {
              f32x4 v[4];
#pragma unroll
              for (int q = 0; q < 4; ++q) if (i + q * NGT < (long)M * PLE / 4) v[q] = p4[i + q * NGT];
#pragma unroll
              for (int q = 0; q < 4; ++q) if (i + q * NGT < (long)M * PLE / 4) { u32x2 w; w.x = cvtpk(v[q][0], v[q][1]); w.y = cvtpk(v[q][2], v[q][3]); o8[i + q * NGT] = w; } } }
        for (long i = gt; i < 4L * M; i += NGT) ss[M + i] = 0.f;
        for (long i = gt; i < (long)NH * DM; i += NGT) { const int h = (int)(i / DM), k = (int)(i % DM); wf[i] = args.in[6][k] * args.in[7][(size_t)k * DIN + 3072 + h]; }
    }
    xcd_barrier(xbar);
    if (tid == 0) { unsigned* barw = (unsigned*)(ws + WS_BAR); bool bal = (G % 8 == 0);
        for (unsigned jx = 0; jx < 16; ++jx) { const unsigned cnt = xb_ld(&barw[XB_XCNT(jx)]); bal = bal && (cnt == (jx < 8 ? (unsigned)(G / 8) : 0u)); }
        bst[7] = bal ? bst[5] * 8u + xbar.x : (unsigned)bx; }
    __syncthreads();
    const int vc = __builtin_amdgcn_readfirstlane((int)bst[7]);
    const int vcu2 = (G % 8 == 0) ? (vc % 8) * (G / 8) + vc / 8 : vc;

#pragma unroll 1
    for (int j = 0; j < 9; ++j) {
        if (j == 2) {
            const int ln = opaque_tid() & 63;
            float wreg[32];
#pragma unroll
            for (int jj = 0; jj < 4; ++jj) { const f32x4 a = *(const f32x4*)(wf + (size_t)wave * DM + 512 * jj + 8 * ln), bq = *(const f32x4*)(wf + (size_t)wave * DM + 512 * jj + 8 * ln + 4);
#pragma unroll
                for (int e = 0; e < 4; ++e) { wreg[8 * jj + e] = a[e]; wreg[8 * jj + 4 + e] = bq[e]; } }
            const float bf = args.in[8][wave];
            for (int m0 = vcu2 * 4; m0 < M; m0 += G * 4) {
                u32x4 pw[4][4]; float sq[4];
#pragma unroll
                for (int q = 0; q < 4; ++q) { sq[q] = ss[M + m0 + q];
#pragma unroll
                    for (int jj = 0; jj < 4; ++jj) pw[q][jj] = *(const u32x4*)(XB + (size_t)(m0 + q) * DM + 512 * jj + 8 * ln); }
#pragma unroll
                for (int q = 0; q < 4; ++q) { float d = 0.f;
#pragma unroll
                    for (int jj = 0; jj < 4; ++jj) { const u32x4 w = pw[q][jj];
                        d += __uint_as_float(w.x << 16) * wreg[8 * jj + 0] + __uint_as_float(w.x & 0xffff0000u) * wreg[8 * jj + 1] + __uint_as_float(w.y << 16) * wreg[8 * jj + 2] + __uint_as_float(w.y & 0xffff0000u) * wreg[8 * jj + 3]
                           + __uint_as_float(w.z << 16) * wreg[8 * jj + 4] + __uint_as_float(w.z & 0xffff0000u) * wreg[8 * jj + 5] + __uint_as_float(w.w << 16) * wreg[8 * jj + 6] + __uint_as_float(w.w & 0xffff0000u) * wreg[8 * jj + 7]; }
                    d = wave_sum(d);
                    if (ln == 0) { const int m = m0 + q; const float f = d * rs_from_ss(sq[q]) + bf; const float lf = fminf(f, 0.f) - log1pf(__expf(-fabsf(f)));
                        logfb[((size_t)(m / SEQ) * NH + wave) * SEQ + (m % SEQ)] = lf; } }
            }
        }
        if (j == 4) {
            for (int g = vcu2; g < 256; g += G) {
                const int b = (g >> 1) >> 4, hh = (g >> 1) & 15, j0 = 2 * (g & 1);
                att::build_table(lds, b, hh, logfb, args.in[17]);
                att::attn_unit(lds, b, hh, 7 - j0, QKB, VT, CAT);
                att::attn_unit(lds, b, hh, 6 - j0, QKB, VT, CAT);
                att::attn_unit(lds, b, hh, j0 + 1, QKB, VT, CAT);
                att::attn_unit(lds, b, hh, j0, QKB, VT, CAT);
            }
            xcd_barrier(xbar);
        }
        pg8::Gemm g; pg8::Epi E; E.ss_in = nullptr; E.base = nullptr; E.of = nullptr; E.ss_out = nullptr; E.proj = nullptr; E.xb_in = nullptr; E.alpha = 0.f; E.ob = nullptr; E.ldc = 0; E.mode = 0;
        switch (j) {
            case 0: g = pg8::Gemm{XB, W1, M, 2 * FF, DM}; E.mode = pg8::EPI_SWIGLU; E.ob = HB; E.ldc = FF; E.ss_in = ss; break;
            case 1: g = pg8::Gemm{HB, WD1, M, DM, FF}; E.mode = pg8::EPI_RESID; E.xb_in = XB; E.ob = XB; E.ss_out = ss + M; E.alpha = 0.5f; break;
            case 2: g = pg8::Gemm{XB, WQK, M, NQK, DM}; E.mode = pg8::EPI_BF16; E.ob = QKB; E.ldc = 0; E.ss_in = ss + M; break;
            case 3: g = pg8::Gemm{WV, XB, NVT, M, DM}; E.mode = pg8::EPI_COLSCALE; E.ob = VT; E.ldc = M; E.ss_in = ss + M; break;
            case 4: g = pg8::Gemm{CAT, WO, M, DM, DM}; E.mode = pg8::EPI_RESID; E.xb_in = XB; E.ob = XB; E.ss_out = ss + 2 * M; E.alpha = 1.0f; break;
            case 5: g = pg8::Gemm{XB, W2, M, 2 * FF, DM}; E.mode = pg8::EPI_SWIGLU; E.ob = HB; E.ldc = FF; E.ss_in = ss + 2 * M; break;
            case 6: g = pg8::Gemm{PB, WPP, M, DM, PLE}; E.mode = pg8::EPI_BF16; E.ob = CAT; E.ldc = DM; break;
            case 7: g = pg8::Gemm{HB, WD2, M, DM, FF}; E.mode = pg8::EPI_RESID; E.xb_in = XB; E.ob = XB; E.ss_out = ss + 3 * M; E.alpha = 0.5f; break;
            default: g = pg8::Gemm{XB, WPG, M, DM, DM}; E.mode = pg8::EPI_PLE; E.xb_in = XB; E.ob = HB; E.ss_in = ss + 3 * M; E.ss_out = ss + 4 * M; E.proj = CAT; break;
        }
        pg8::StaticOrder S; S.init(g.M, g.N, G, vc, g.M == NVT ? 8 : pg8::WGM);
        pg8::gemm_phase(lds, g, S, E);
        if (j != 2 && j != 6) xcd_barrier(xbar);
    }

    {
        const float* gf = args.in[18];
        for (int m0 = gw * 4; m0 < M; m0 += NGW * 4) {
            u32x2 w[4][8]; float r[4];
#pragma unroll
            for (int q = 0; q < 4; ++q) { const u32x2* xr = (const u32x2*)(HB + (size_t)(m0 + q) * DM) + lane; r[q] = ss[4 * M + m0 + q];
#pragma unroll
                for (int jj = 0; jj < 8; ++jj) w[q][jj] = xr[64 * jj]; }
            const f32x4* g4 = (const f32x4*)gf + lane;
#pragma unroll
            for (int q = 0; q < 4; ++q) { f32x4* orow = (f32x4*)(out + (size_t)(m0 + q) * DM) + lane; const float rq = rs_from_ss(r[q]);
#pragma unroll
                for (int jj = 0; jj < 8; ++jj) { const f32x4 gg = g4[64 * jj]; f32x4 v;
                    v[0] = __uint_as_float(w[q][jj].x << 16); v[1] = __uint_as_float(w[q][jj].x & 0xffff0000u); v[2] = __uint_as_float(w[q][jj].y << 16); v[3] = __uint_as_float(w[q][jj].y & 0xffff0000u);
                    orow[64 * jj] = v * rq * gg; } }
        }
    }
}

extern "C" void kernel_launch(void* const* d_in, const int* in_sizes, int n_in, void* d_out, int out_size, void* d_ws, size_t ws_size, hipStream_t stream) {
    static int grid = 0;
    if (grid == 0) {
        if (n_in != 19 || out_size != M * DM || ws_size < WS_END) { fprintf(stderr, "kernel_launch: unexpected problem (n_in %d, out %d, ws %zu)\n", n_in, out_size, ws_size); grid = -1; return; }
        int dev = 0, cus = 0, per_cu = 0;
        hipGetDevice(&dev);
        hipDeviceGetAttribute(&cus, hipDeviceAttributeMultiprocessorCount, dev);
        hipFuncSetAttribute((const void*)fwd_megakernel, hipFuncAttributeMaxDynamicSharedMemorySize, LDS_BYTES);
        hipOccupancyMaxActiveBlocksPerMultiprocessor(&per_cu, (const void*)fwd_megakernel, NWAVES * 64, LDS_BYTES);
        if (per_cu < 1) { fprintf(stderr, "kernel_launch: occupancy query says %d blocks per CU\n", per_cu); per_cu = 1; }
        (void)hipGetLastError();
        grid = cus * 1;
    }
    if (grid < 0) return;
    Args a{};
    for (int i = 0; i < 19; ++i) a.in[i] = (const float*)d_in[i];
    a.out = (float*)d_out; a.ws = (unsigned char*)d_ws;
    void* kargs[] = {&a};
    hipError_t e = hipLaunchCooperativeKernel((const void*)fwd_megakernel, dim3(grid), dim3(NWAVES * 64), kargs, LDS_BYTES, stream);
    if (e != hipSuccess) fprintf(stderr, "cooperative launch failed: %s (grid %d)\n", hipGetErrorString(e), grid);
}
```

```cpp
#include <hip/hip_runtime.h>
#include <hip/hip_cooperative_groups.h>
#include <cstdio>
#include <cstdint>
namespace cg = cooperative_groups;

#define LAS __attribute__((address_space(3)))
#define GAS __attribute__((address_space(1)))
typedef unsigned short bf16_t;
typedef short bf16x8 __attribute__((ext_vector_type(8)));
typedef float f32x4 __attribute__((ext_vector_type(4)));
typedef float f32x2 __attribute__((ext_vector_type(2)));
typedef float f32x16 __attribute__((ext_vector_type(16)));
typedef unsigned u32x4 __attribute__((ext_vector_type(4)));
typedef unsigned u32x2 __attribute__((ext_vector_type(2)));
typedef __bf16 bf16x2_t __attribute__((ext_vector_type(2)));

constexpr int BATCH = 8, SEQ = 2048, DM = 2048, FF = 5632, PLE = 256, NH = 8, HD = 128;
constexpr int M = BATCH * SEQ;
constexpr int NQK = 4096;
constexpr int NVT = 2048;
constexpr int DIN = 6152;
constexpr float RMS_EPS = 1e-6f;
constexpr float LOG2E = 1.4426950408889634f;

constexpr size_t MiB = 1u << 20;
constexpr size_t WS_SS = 0;
constexpr size_t WS_BAR = 384 * 1024;
constexpr size_t WS_LOGF = 512 * 1024;
constexpr size_t WS_WF = 1 * MiB;
constexpr size_t WS_W1 = 2 * MiB;
constexpr size_t WS_WD1 = 46 * MiB;
constexpr size_t WS_VT = 2 * MiB;
constexpr size_t WS_WQK = 68 * MiB;
constexpr size_t WS_WV = 84 * MiB;
constexpr size_t WS_WO = 92 * MiB;
constexpr size_t WS_W2 = 100 * MiB;
constexpr size_t WS_WD2 = 144 * MiB;
constexpr size_t WS_WPG = 166 * MiB;
constexpr size_t WS_WPP = 174 * MiB;
constexpr size_t WS_PB = 176 * MiB;
constexpr size_t WS_XB = 184 * MiB;
constexpr size_t WS_H = 248 * MiB;
constexpr size_t WS_QK = 248 * MiB;
constexpr size_t WS_CAT = 424 * MiB;
constexpr size_t WS_END = 488 * MiB;

__device__ __forceinline__ unsigned cvtpk(float lo, float hi) { f32x2 v = {lo, hi}; bf16x2_t b = __builtin_convertvector(v, bf16x2_t); return __builtin_bit_cast(unsigned, b); }
__device__ __forceinline__ float wave_sum(float v) {
#pragma unroll
    for (int o = 1; o < 64; o <<= 1) v += __shfl_xor(v, o);
    return v;
}
__device__ __forceinline__ int opaque_tid() { int t = threadIdx.x; asm volatile("" : "+v"(t)); return t; }
__device__ __forceinline__ float rs_from_ss(float ss) { return rsqrtf(ss * (1.0f / DM) + RMS_EPS); }

namespace pg8 {
constexpr int BM = 256, BK = 64, HALF = 128, HTB = HALF * BK * 2, STAGE_BYTES = 8 * HTB, NXCD = 8, WGM = 4;
__host__ __device__ __forceinline__ int lds_byte(int r, int c) { const int st = (r >> 4) * 2 + (c >> 5), rr = r & 15, cc = c & 31, ob = rr * 64 + cc * 2; return st * 1024 + (ob ^ (((ob >> 9) & 1) << 5)); }
__host__ __device__ __forceinline__ void stage_rc(int b, int& R, int& C) { const int st = b / 1024, sb = b % 1024, swz = sb ^ (((sb >> 9) & 1) << 5); R = (st >> 1) * 16 + swz / 64; C = (st & 1) * 32 + (swz % 64) / 2; }
__host__ __device__ __forceinline__ int perm32(int rho) { const int n = rho >> 4, i = rho & 15; return 8 * (i >> 2) + 4 * n + (i & 3); }

struct Unit { int pm, pn; };
struct Gemm { const bf16_t* A; const bf16_t* Bt; int M, N, K; };

struct StaticOrder {
    int nM, nN, nwg, G, c, wgm;
    __device__ void init(int M_, int N_, int G_, int c_, int wgm_) { nM = M_ / BM; nN = N_ / BM; nwg = nM * nN; G = G_; c = c_; wgm = wgm_; }
    __device__ bool next(int i, Unit& u) const {
        const long L = (long)i * G + c; if (L >= nwg) return false;
        int wgid = (int)L; { const int q = nwg / NXCD, r = nwg % NXCD, xcd = wgid % NXCD, off = wgid / NXCD; wgid = (xcd < r ? xcd * (q + 1) : r * (q + 1) + (xcd - r) * q) + off; }
        const int nig = wgm * nN, gid = wgid / nig, fm = gid * wgm, gsz = (nM - fm) < wgm ? (nM - fm) : wgm;
        u.pm = fm + ((wgid % nig) % gsz); u.pn = (wgid % nig) / gsz; return true;
    }
};

enum { EPI_SWIGLU = 0, EPI_RESID = 1, EPI_BF16 = 2, EPI_COLSCALE = 3, EPI_PLE = 4 };
struct Epi {
    int mode;
    bf16_t* ob; int ldc;
    const float* ss_in;
    const float* base; float* of;
    float* ss_out;
    const bf16_t* proj;
    const bf16_t* xb_in;
    float alpha;
};
__device__ __forceinline__ void unpack8(const u32x4 w, f32x4& a, f32x4& b) {
    a[0] = __uint_as_float(w.x << 16); a[1] = __uint_as_float(w.x & 0xffff0000u); a[2] = __uint_as_float(w.y << 16); a[3] = __uint_as_float(w.y & 0xffff0000u);
    b[0] = __uint_as_float(w.z << 16); b[1] = __uint_as_float(w.z & 0xffff0000u); b[2] = __uint_as_float(w.w << 16); b[3] = __uint_as_float(w.w & 0xffff0000u);
}
__device__ __forceinline__ float silu_mul(float g, float u) { return g * __builtin_amdgcn_rcpf(1.0f + __expf(-g)) * u; }
__device__ __forceinline__ float sigmoidf_(float g) { return __builtin_amdgcn_rcpf(1.0f + __expf(-g)); }

__device__ __forceinline__ void epilogue(const Epi& E, f32x4 (&acc)[2][2][4][2], const Unit& u, int wr, int wc, int fr, int fq, const LAS float* rsl) {
    const int row0 = u.pm * BM + wr * 64 + fr;
    if (E.mode == EPI_SWIGLU) {
        const int col0 = u.pn * HALF + wc * 32 + 8 * fq;
        float rr[8];
#pragma unroll
        for (int i = 0; i < 8; ++i) rr[i] = rsl[(i >> 2) * 64 + (i & 3) * 16 + fr];
#pragma unroll
        for (int ai = 0; ai < 2; ++ai)
#pragma unroll
            for (int m = 0; m < 4; ++m) {
                const int row = row0 + ai * HALF + m * 16; const float r = rr[ai * 4 + m], nr = -r * LOG2E, r2 = r * r;
                float ov[8];
#pragma unroll
                for (int n = 0; n < 2; ++n)
#pragma unroll
                    for (int e = 0; e < 4; ++e) { const float ga = acc[ai][0][m][n][e], ua = acc[ai][1][m][n][e];
                        ov[4 * n + e] = (ga * ua) * r2 * __builtin_amdgcn_rcpf(1.0f + __builtin_amdgcn_exp2f(ga * nr)); }
                u32x4 w; w.x = cvtpk(ov[0], ov[1]); w.y = cvtpk(ov[2], ov[3]); w.z = cvtpk(ov[4], ov[5]); w.w = cvtpk(ov[6], ov[7]);
                *(u32x4*)(E.ob + (size_t)row * E.ldc + col0) = w;
            }
    } else if (E.mode == EPI_RESID) {
        const int col0 = u.pn * BM + wc * 32 + 8 * fq;
        if (E.base) {
#pragma unroll
            for (int gi = 0; gi < 4; ++gi) { const int ai = gi >> 1, mh = gi & 1;
                f32x4 bb[2][2][2];
#pragma unroll
                for (int mm = 0; mm < 2; ++mm)
#pragma unroll
                    for (int bj = 0; bj < 2; ++bj) { const float* p = E.base + (size_t)(row0 + ai * HALF + (2 * mh + mm) * 16) * DM + col0 + bj * HALF; bb[mm][bj][0] = *(const f32x4*)p; bb[mm][bj][1] = *(const f32x4*)(p + 4); }
                __builtin_amdgcn_sched_barrier(0);
#pragma unroll
                for (int mm = 0; mm < 2; ++mm) { const int m = 2 * mh + mm; float sq = 0.f; const size_t off = (size_t)(row0 + ai * HALF + m * 16) * DM + col0;
#pragma unroll
                    for (int bj = 0; bj < 2; ++bj) { const f32x4 v0 = bb[mm][bj][0] + acc[ai][bj][m][0] * E.alpha, v1 = bb[mm][bj][1] + acc[ai][bj][m][1] * E.alpha;
                        u32x4 w; w.x = cvtpk(v0[0], v0[1]); w.y = cvtpk(v0[2], v0[3]); w.z = cvtpk(v1[0], v1[1]); w.w = cvtpk(v1[2], v1[3]);
                        *(u32x4*)(E.ob + off + bj * HALF) = w;
                        sq += (v0[0] * v0[0] + v0[1] * v0[1]) + (v0[2] * v0[2] + v0[3] * v0[3]) + (v1[0] * v1[0] + v1[1] * v1[1]) + (v1[2] * v1[2] + v1[3] * v1[3]); }
                    sq += __shfl_xor(sq, 16); sq += __shfl_xor(sq, 32); if (fq == 0) unsafeAtomicAdd(E.ss_out + row0 + ai * HALF + m * 16, sq); }
                __builtin_amdgcn_sched_barrier(0);
            }
        } else {
#pragma unroll
            for (int ai = 0; ai < 2; ++ai) {
                u32x4 xw[4][2];
#pragma unroll
                for (int m = 0; m < 4; ++m)
#pragma unroll
                    for (int bj = 0; bj < 2; ++bj) xw[m][bj] = *(const u32x4*)(E.xb_in + (size_t)(row0 + ai * HALF + m * 16) * DM + col0 + bj * HALF);
                __builtin_amdgcn_sched_barrier(0);
#pragma unroll
                for (int m = 0; m < 4; ++m) { float sq = 0.f; const size_t off = (size_t)(row0 + ai * HALF + m * 16) * DM + col0;
#pragma unroll
                    for (int bj = 0; bj < 2; ++bj) { f32x4 b0, b1; unpack8(xw[m][bj], b0, b1);
                        const f32x4 v0 = b0 + acc[ai][bj][m][0] * E.alpha, v1 = b1 + acc[ai][bj][m][1] * E.alpha;
                        u32x4 w; w.x = cvtpk(v0[0], v0[1]); w.y = cvtpk(v0[2], v0[3]); w.z = cvtpk(v1[0], v1[1]); w.w = cvtpk(v1[2], v1[3]);
                        *(u32x4*)(E.ob + off + bj * HALF) = w;
                        sq += (v0[0] * v0[0] + v0[1] * v0[1]) + (v0[2] * v0[2] + v0[3] * v0[3]) + (v1[0] * v1[0] + v1[1] * v1[1]) + (v1[2] * v1[2] + v1[3] * v1[3]); }
                    sq += __shfl_xor(sq, 16); sq += __shfl_xor(sq, 32); if (fq == 0) unsafeAtomicAdd(E.ss_out + row0 + ai * HALF + m * 16, sq); }
                __builtin_amdgcn_sched_barrier(0);
            }
        }
    } else if (E.mode == EPI_PLE) {
        const int col0 = u.pn * BM + wc * 32 + 8 * fq;
        float rr[8];
#pragma unroll
        for (int i = 0; i < 8; ++i) rr[i] = rsl[(i >> 2) * 64 + (i & 3) * 16 + fr];
        u32x4 xw[2][2], pw[2][2];
#pragma unroll
        for (int bj = 0; bj < 2; ++bj) { const size_t off = (size_t)row0 * DM + col0 + bj * HALF; xw[0][bj] = *(const u32x4*)(E.xb_in + off); pw[0][bj] = *(const u32x4*)(E.proj + off); }
#pragma unroll
        for (int gi = 0; gi < 8; ++gi) { const int ai = gi >> 2, m = gi & 3, par = gi & 1;
            if (gi < 7) { const int ai2 = (gi + 1) >> 2, m2 = (gi + 1) & 3;
#pragma unroll
                for (int bj = 0; bj < 2; ++bj) { const size_t off = (size_t)(row0 + ai2 * HALF + m2 * 16) * DM + col0 + bj * HALF; xw[par ^ 1][bj] = *(const u32x4*)(E.xb_in + off); pw[par ^ 1][bj] = *(const u32x4*)(E.proj + off); } }
            __builtin_amdgcn_sched_barrier(0);
            float sq = 0.f; const size_t off = (size_t)(row0 + ai * HALF + m * 16) * DM + col0; const float r = rr[gi];
#pragma unroll
            for (int bj = 0; bj < 2; ++bj) { f32x4 b0, b1, p0, p1; unpack8(xw[par][bj], b0, b1); unpack8(pw[par][bj], p0, p1);
                const f32x4 a0 = acc[ai][bj][m][0] * r, a1 = acc[ai][bj][m][1] * r; f32x4 v0, v1;
#pragma unroll
                for (int e = 0; e < 4; ++e) { v0[e] = b0[e] + sigmoidf_(a0[e]) * p0[e]; v1[e] = b1[e] + sigmoidf_(a1[e]) * p1[e]; }
                { u32x4 w; w.x = cvtpk(v0[0], v0[1]); w.y = cvtpk(v0[2], v0[3]); w.z = cvtpk(v1[0], v1[1]); w.w = cvtpk(v1[2], v1[3]); *(u32x4*)(E.ob + off + bj * HALF) = w; }
                sq += (v0[0] * v0[0] + v0[1] * v0[1]) + (v0[2] * v0[2] + v0[3] * v0[3]) + (v1[0] * v1[0] + v1[1] * v1[1]) + (v1[2] * v1[2] + v1[3] * v1[3]); }
            sq += __shfl_xor(sq, 16); sq += __shfl_xor(sq, 32); if (fq == 0) unsafeAtomicAdd(E.ss_out + row0 + ai * HALF + m * 16, sq);
            __builtin_amdgcn_sched_barrier(0);
        }
    } else {
        const int col0 = u.pn * BM + wc * 32 + 8 * fq;
        f32x4 cs[2][2]; float rr[8];
#pragma unroll
        for (int i = 0; i < 8; ++i) rr[i] = rsl[(i >> 2) * 64 + (i & 3) * 16 + fr];
#pragma unroll
        for (int bj = 0; bj < 2; ++bj)
#pragma unroll
            for (int n = 0; n < 2; ++n) {
                cs[bj][n] = (f32x4){1.f, 1.f, 1.f, 1.f};
                if (E.mode == EPI_COLSCALE) { const f32x4 t = *(const f32x4*)(E.ss_in + col0 + bj * HALF + 4 * n);
#pragma unroll
                    for (int e = 0; e < 4; ++e) cs[bj][n][e] = rs_from_ss(t[e]); }
            }
        __builtin_amdgcn_sched_barrier(0);
#pragma unroll
        for (int ai = 0; ai < 2; ++ai)
#pragma unroll
            for (int m = 0; m < 4; ++m) {
                const int row = row0 + ai * HALF + m * 16;
                const float r = (E.mode == EPI_BF16 && E.ss_in) ? rr[ai * 4 + m] : 1.f;
#pragma unroll
                for (int bj = 0; bj < 2; ++bj) {
                    const f32x4 v0 = acc[ai][bj][m][0] * cs[bj][0] * r, v1 = acc[ai][bj][m][1] * cs[bj][1] * r;
                    u32x4 w; w.x = cvtpk(v0[0], v0[1]); w.y = cvtpk(v0[2], v0[3]); w.z = cvtpk(v1[0], v1[1]); w.w = cvtpk(v1[2], v1[3]);
                    size_t doff;
                    if (E.mode == EPI_COLSCALE) { const int c = col0 + bj * HALF, bb = c >> 11, sq = c & 2047;
                        doff = ((((size_t)bb * 16 + (row >> 7)) * 32 + (sq >> 6)) * 128 + (row & 127)) * 64 + (((((sq & 63) >> 3) ^ ((row >> 1) & 7))) << 3); }
                    else if (E.ldc == 0) { const int c = col0 + bj * HALF;
                        doff = ((size_t)((row >> 11) * 32 + (c >> 7)) * SEQ + (row & 2047)) * HD + (((((c & 127) >> 3) ^ (row & 15))) << 3); }
                    else doff = (size_t)row * E.ldc + col0 + bj * HALF;
                    *(u32x4*)(E.ob + doff) = w;
                }
            }
    }
}

__device__ __forceinline__ void gemm_phase(LAS unsigned char* lds, const Gemm g, const StaticOrder& S, const Epi& E) {
    const int tid = opaque_tid(), wid = __builtin_amdgcn_readfirstlane(tid >> 6), lane = tid & 63, wr = wid >> 2, wc = wid & 3, fr = lane & 15, fq = lane >> 4;
    const int K = g.K, nt = K / BK;
    unsigned voffA[2], voffB[2];
#pragma unroll
    for (int i = 0; i < 2; ++i) { int R, C; stage_rc(tid * 16 + i * 8192, R, C); const int Rb = (R & ~31) + perm32(R & 31);
        voffA[i] = (unsigned)(R * K + C) * 2u; voffB[i] = (unsigned)(Rb * K + C) * 2u; }
    const size_t kstep = (size_t)(BK * 2);
    const size_t hstep = (size_t)HALF * K * 2;
    const size_t tstep = 2 * hstep;
    const unsigned ldsw = (unsigned)wid * 1024u;
    const int aoff = lds_byte(wr * 64 + fr, fq * 8), boff = lds_byte(wc * 32 + fr, fq * 8);
#define PG8_SA(b, h) (((b) * 2 + (h)) * HTB)
#define PG8_SB(b, h) ((4 + (b) * 2 + (h)) * HTB)
#define PG8_STAGE(bufoff, gbase, voff) do { _Pragma("unroll") for (int _i = 0; _i < 2; ++_i) \
        __builtin_amdgcn_global_load_lds((const unsigned*)((const char*)(gbase) + (voff)[_i]), (LAS unsigned*)(lds + (bufoff) + ldsw + _i * 8192), 16, 0, 0); } while (0)
#define PG8_LDA(dst, b, h) do { _Pragma("unroll") for (int m = 0; m < 4; ++m) _Pragma("unroll") for (int k = 0; k < 2; ++k) dst[m][k] = *(const LAS bf16x8*)(lds + PG8_SA(b, h) + aoff + m * 2048 + k * 1024); } while (0)
#define PG8_LDB(dst, b, h) do { _Pragma("unroll") for (int n = 0; n < 2; ++n) _Pragma("unroll") for (int k = 0; k < 2; ++k) dst[n][k] = *(const LAS bf16x8*)(lds + PG8_SB(b, h) + boff + n * 2048 + k * 1024); } while (0)
#define PG8_MMA(ai, bj, At, Bt) do { __builtin_amdgcn_s_setprio(1); _Pragma("unroll") for (int m = 0; m < 4; ++m) _Pragma("unroll") for (int n = 0; n < 2; ++n) _Pragma("unroll") for (int k = 0; k < 2; ++k) \
        acc[ai][bj][m][n] = __builtin_amdgcn_mfma_f32_16x16x32_bf16(Bt[n][k], At[m][k], acc[ai][bj][m][n], 0, 0, 0); __builtin_amdgcn_s_setprio(0); } while (0)
#define PG8_WAIT_V(n) asm volatile("s_waitcnt vmcnt(" #n ")" ::: "memory")
#define PG8_WAIT_L(n) asm volatile("s_waitcnt lgkmcnt(" #n ")" ::: "memory")
#define PG8_BAR __builtin_amdgcn_s_barrier()
#define PG8_SCHED __builtin_amdgcn_sched_barrier(0)
    Unit cur, nxt; int ui = 0;
    if (!S.next(0, cur)) return;
    f32x4 acc[2][2][4][2];
#pragma unroll
    for (int a = 0; a < 2; ++a)
#pragma unroll
        for (int b = 0; b < 2; ++b)
#pragma unroll
            for (int m = 0; m < 4; ++m)
#pragma unroll
                for (int n = 0; n < 2; ++n) acc[a][b][m][n] = (f32x4){0.f, 0.f, 0.f, 0.f};
    bf16x8 At[4][2], B0[2][2], B1[2][2];
    const char* cA = (const char*)g.A + (size_t)cur.pm * tstep; const char* cB = (const char*)g.Bt + (size_t)cur.pn * tstep;
    const bool rowss = (E.ss_in != nullptr) && (E.mode != EPI_COLSCALE);
    LAS float* rsl = (LAS float*)(lds + STAGE_BYTES + wid * 512);
    int cached_pm = cur.pm; float ssA = 0.f, ssB = 0.f;
    if (rowss) { const float* sp = E.ss_in + cur.pm * BM + wr * 64 + lane; ssA = sp[0]; ssB = sp[HALF]; }
    PG8_STAGE(PG8_SB(0, 0), cB, voffB); PG8_STAGE(PG8_SB(0, 1), cB + hstep, voffB); PG8_STAGE(PG8_SA(0, 0), cA, voffA); PG8_STAGE(PG8_SA(0, 1), cA + hstep, voffA);
    if (wr == 1) PG8_BAR;
    PG8_WAIT_V(2); PG8_BAR;
    PG8_STAGE(PG8_SB(1, 0), cB + kstep, voffB); PG8_STAGE(PG8_SA(1, 0), cA + kstep, voffA); PG8_STAGE(PG8_SB(1, 1), cB + hstep + kstep, voffB);
    PG8_WAIT_V(6); PG8_BAR;
    if (rowss) { rsl[lane] = rs_from_ss(ssA); rsl[64 + lane] = rs_from_ss(ssB); }
    for (;;) {
        const bool has_next = S.next(ui + 1, nxt);
        const char* nA = has_next ? (const char*)g.A + (size_t)nxt.pm * tstep : cA; const char* nB = has_next ? (const char*)g.Bt + (size_t)nxt.pn * tstep : cB;
        for (int t = 0; t < nt; t += 2) {
            const bool last = (t == nt - 2);
            const char* a1 = cA + (size_t)(t + 1) * kstep;
            const char* a2 = last ? nA : cA + (size_t)(t + 2) * kstep; const char* b2 = last ? nB : cB + (size_t)(t + 2) * kstep;
            const char* a3 = a2 + kstep; const char* b3 = b2 + kstep;
            PG8_LDB(B0, 0, 0); PG8_LDB(B1, 0, 1); PG8_SCHED; PG8_LDA(At, 0, 0); PG8_STAGE(PG8_SA(1, 1), a1 + hstep, voffA);
            PG8_WAIT_V(8); PG8_WAIT_L(0); PG8_BAR; PG8_MMA(0, 0, At, B0); PG8_MMA(0, 1, At, B1); PG8_BAR; PG8_SCHED;
            PG8_LDA(At, 0, 1); PG8_STAGE(PG8_SB(0, 0), b2, voffB); PG8_STAGE(PG8_SB(0, 1), b2 + hstep, voffB); PG8_STAGE(PG8_SA(0, 0), a2, voffA);
            PG8_WAIT_V(8); PG8_WAIT_L(0); PG8_BAR; PG8_MMA(1, 0, At, B0); PG8_MMA(1, 1, At, B1); PG8_BAR; PG8_SCHED;
            PG8_LDB(B0, 1, 0); PG8_LDB(B1, 1, 1); PG8_SCHED; PG8_LDA(At, 1, 0); PG8_STAGE(PG8_SA(0, 1), a2 + hstep, voffA);
            PG8_WAIT_V(8); PG8_WAIT_L(0); PG8_BAR; PG8_MMA(0, 0, At, B0); PG8_MMA(0, 1, At, B1); PG8_BAR; PG8_SCHED;
            PG8_LDA(At, 1, 1); PG8_STAGE(PG8_SB(1, 0), b3, voffB); PG8_STAGE(PG8_SB(1, 1), b3 + hstep, voffB); PG8_STAGE(PG8_SA(1, 0), a3, voffA);
            PG8_WAIT_V(8); PG8_WAIT_L(0); PG8_BAR; PG8_MMA(1, 0, At, B0); PG8_MMA(1, 1, At, B1); PG8_BAR; PG8_SCHED;
        }
        if (wr == 0) PG8_BAR;
        epilogue(E, acc, cur, wr, wc, fr, fq, rsl);
        if (!has_next) break;
#pragma unroll
        for (int a = 0; a < 2; ++a)
#pragma unroll
            for (int b = 0; b < 2; ++b)
#pragma unroll
                for (int m = 0; m < 4; ++m)
#pragma unroll
                    for (int n = 0; n < 2; ++n) acc[a][b][m][n] = (f32x4){0.f, 0.f, 0.f, 0.f};
        cur = nxt; cA = nA; cB = nB; ++ui;
        if (rowss && cur.pm != cached_pm) { const float* sp = E.ss_in + cur.pm * BM + wr * 64 + lane; const float a_ = sp[0], b_ = sp[HALF]; rsl[lane] = rs_from_ss(a_); rsl[64 + lane] = rs_from_ss(b_); cached_pm = cur.pm; }
        if (wr == 1) PG8_BAR;
    }
    PG8_WAIT_V(0);
    PG8_BAR;
#undef PG8_SA
#undef PG8_SB
#undef PG8_STAGE
#undef PG8_LDA
#undef PG8_LDB
#undef PG8_MMA
#undef PG8_WAIT_V
#undef PG8_WAIT_L
#undef PG8_BAR
#undef PG8_SCHED
}
}

namespace att {
constexpr int KBUF = 16384, VBUF = 16384, NSLOT = 3;
constexpr int OFF_K = 0, OFF_V = NSLOT * KBUF, OFF_TAB = OFF_V + NSLOT * VBUF, TAB_N = 2048 + 64, OFF_SCAN = OFF_TAB + TAB_N * 4, LDS_BYTES = OFF_SCAN + 64;
constexpr float NEG_INF = -__builtin_inff();

__device__ __forceinline__ int pi32(int rho) { return (rho & 0x13) | ((rho & 4) << 1) | ((rho & 8) >> 1); }

__device__ __forceinline__ void build_table(LAS unsigned char* lds, int b, int hh, const float* lgf, const float* rel_table) {
    LAS float* tab = (LAS float*)(lds + OFF_TAB); LAS float* scan = (LAS float*)(lds + OFF_SCAN);
    const int tid = opaque_tid(), lane = tid & 63, wid = tid >> 6;
    if (hh < NH) {
        f32x4 a = ((const f32x4*)(lgf + (size_t)(b * NH + hh) * SEQ))[tid];
        a[1] += a[0]; a[2] += a[1]; a[3] += a[2];
        float v = a[3];
#pragma unroll
        for (int o = 1; o < 64; o <<= 1) { const float t = __shfl_up(v, o); if (lane >= o) v += t; }
        if (lane == 63) scan[wid] = v;
        __syncthreads();
        float pre = v - a[3];
        for (int w = 0; w < wid; ++w) pre += scan[w];
#pragma unroll
        for (int e = 0; e < 4; ++e) tab[4 * tid + e] = -(a[e] + pre) * LOG2E;
    } else {
        const int h = hh - NH;
        for (int x = tid; x < TAB_N; x += 512) {
            const int dl = 2047 - x; float v = NEG_INF;
            if (dl >= 0) {
                const int mult = (dl <= 128 ? 1 : 0) + (((dl & 3) == 0 && dl <= 512) ? 1 : 0) + (((dl & 15) == 0) ? 1 : 0);
                if (mult > 0) {
                    int bucket = dl;
                    if (dl >= 16) { const float d = (float)dl; int lg = 16 + (int)(logf(d / 16.0f) / 4.852030263919617f * 16.0f); bucket = lg < 31 ? lg : 31; }
                    v = (rel_table[bucket * NH + h] + logf((float)mult)) * LOG2E;
                }
            }
            tab[x] = v;
        }
    }
    __syncthreads();
}

__device__ __forceinline__ void attn_unit(LAS unsigned char* lds, int b, int hh, int qb, const bf16_t* QK, const bf16_t* VT, bf16_t* CAT) {
    const int tid = opaque_tid(), lane = tid & 63, r32 = lane & 31, hi = lane >> 5; const int wid = __builtin_amdgcn_readfirstlane(tid >> 6);
    const bool fox = hh < NH;
    const bool lead = wid < 4;
    const int qch = fox ? hh : hh + 8, kch = qch + 8;
    const int q0 = qb * 256 + wid * 32, qpos = q0 + r32;
    const LAS float* tab = (const LAS float*)(lds + OFF_TAB);
    const float C = 0.08838834764831845f * LOG2E;
    const int nt = (qb + 1) * 4;
    const char* Kg = (const char*)(QK + (size_t)(b * 32 + kch) * SEQ * HD) + wid * 2048 + lane * 16;
    const char* Vg = (const char*)(VT + (size_t)(b * 16 + hh) * SEQ * HD) + wid * 2048 + lane * 16;
#define ATT_DMAK(t) do { const int sl_ = (t) % NSLOT; _Pragma("unroll") for (int i = 0; i < 2; ++i) \
        __builtin_amdgcn_global_load_lds((const unsigned*)(Kg + (size_t)(t) * 16384 + i * 1024), (LAS unsigned*)(lds + OFF_K + sl_ * KBUF + wid * 2048 + i * 1024), 16, 0, 0); } while (0)
#define ATT_DMAV(t) do { const int sl_ = (t) % NSLOT; _Pragma("unroll") for (int i = 0; i < 2; ++i) \
        __builtin_amdgcn_global_load_lds((const unsigned*)(Vg + (size_t)(t) * 16384 + i * 1024), (LAS unsigned*)(lds + OFF_V + sl_ * VBUF + wid * 2048 + i * 1024), 16, 0, 0); } while (0)
    ATT_DMAK(0); ATT_DMAK(1); ATT_DMAV(0);
    bf16x8 qf[8];
    { const bf16_t* Qp = QK + ((size_t)(b * 32 + qch) * SEQ + qpos) * HD;
#pragma unroll
      for (int d0 = 0; d0 < 8; ++d0) qf[d0] = *(const bf16x8*)(Qp + (((2 * d0 + hi) ^ (qpos & 15)) << 3)); }
    const int krow = pi32(r32);
    int koff[8];
#pragma unroll
    for (int d0 = 0; d0 < 8; ++d0) koff[d0] = krow * 256 + (((2 * d0 + hi) ^ (krow & 15)) << 4);
    int voff[4];
#pragma unroll
    for (int c = 0; c < 4; ++c) voff[c] = r32 * 128 + (((2 * c + hi) ^ ((r32 >> 1) & 7)) << 4);
    f32x16 o[4];
#pragma unroll
    for (int d = 0; d < 4; ++d)
#pragma unroll
        for (int i = 0; i < 16; ++i) o[d][i] = 0.f;
    float mrun = -1e30f, lrun = 0.f;
    f32x16 s0, s1;
    bf16x8 pf[4];
    bool v0 = false, v1 = false, pv0 = false, pv1 = false;
#pragma unroll
    for (int i = 0; i < 16; ++i) { s0[i] = 0.f; s1[i] = 0.f; }
#pragma unroll
    for (int i = 0; i < 4; ++i) pf[i] = (bf16x8){0, 0, 0, 0, 0, 0, 0, 0};

#define ATT_QK(t_) do { const int kb0_ = (t_) * 64; v0 = (kb0_ <= q0 + 31); v1 = (kb0_ + 32 <= q0 + 31); \
        const LAS unsigned char* kp = lds + OFF_K + ((t_) % NSLOT) * KBUF; \
        if (v0) { _Pragma("unroll") for (int i = 0; i < 16; ++i) s0[i] = 0.f; bf16x8 kf[8]; \
            _Pragma("unroll") for (int d0 = 0; d0 < 8; ++d0) kf[d0] = *(const LAS bf16x8*)(kp + koff[d0]); \
            __builtin_amdgcn_sched_barrier(0); \
            _Pragma("unroll") for (int d0 = 0; d0 < 8; ++d0) s0 = __builtin_amdgcn_mfma_f32_32x32x16_bf16(kf[d0], qf[d0], s0, 0, 0, 0); \
            __builtin_amdgcn_sched_barrier(0); } \
        if (v1) { _Pragma("unroll") for (int i = 0; i < 16; ++i) s1[i] = 0.f; bf16x8 kf[8]; \
            _Pragma("unroll") for (int d0 = 0; d0 < 8; ++d0) kf[d0] = *(const LAS bf16x8*)(kp + 8192 + koff[d0]); \
            __builtin_amdgcn_sched_barrier(0); \
            _Pragma("unroll") for (int d0 = 0; d0 < 8; ++d0) s1 = __builtin_amdgcn_mfma_f32_32x32x16_bf16(kf[d0], qf[d0], s1, 0, 0, 0); \
            __builtin_amdgcn_sched_barrier(0); } \
    } while (0)

#define ATT_BIAS(SV, kbase_) do { \
        if (fox) { \
            if ((kbase_) + 31 > q0) { \
                _Pragma("unroll") for (int s = 0; s < 2; ++s) { const int kb = (kbase_) + 16 * s + 8 * hi; \
                    const f32x4 c0 = *(const LAS f32x4*)(tab + kb), c1 = *(const LAS f32x4*)(tab + kb + 4); \
                    _Pragma("unroll") for (int j = 0; j < 8; ++j) { const float ck = j < 4 ? c0[j & 3] : c1[j & 3]; float v = __builtin_fmaf(SV[8 * s + j], C, ck); \
                        if (kb + j > qpos) v = NEG_INF; SV[8 * s + j] = v; } } \
            } else { \
                _Pragma("unroll") for (int s = 0; s < 2; ++s) { const int kb = (kbase_) + 16 * s + 8 * hi; \
                    const f32x4 c0 = *(const LAS f32x4*)(tab + kb), c1 = *(const LAS f32x4*)(tab + kb + 4); \
                    _Pragma("unroll") for (int j = 0; j < 8; ++j) { const float ck = j < 4 ? c0[j & 3] : c1[j & 3]; SV[8 * s + j] = __builtin_fmaf(SV[8 * s + j], C, ck); } } \
            } \
        } else { \
            _Pragma("unroll") for (int s = 0; s < 2; ++s) { const int ix = 2047 - qpos + (kbase_) + 16 * s + 8 * hi; \
                _Pragma("unroll") for (int j = 0; j < 8; ++j) SV[8 * s + j] = __builtin_fmaf(SV[8 * s + j], C, tab[ix + j]); } } \
    } while (0)

#define ATT_PACK(dst, SV, s_) do { u32x4 w_; w_.x = cvtpk(SV[8 * (s_)], SV[8 * (s_) + 1]); w_.y = cvtpk(SV[8 * (s_) + 2], SV[8 * (s_) + 3]); \
        w_.z = cvtpk(SV[8 * (s_) + 4], SV[8 * (s_) + 5]); w_.w = cvtpk(SV[8 * (s_) + 6], SV[8 * (s_) + 7]); dst = __builtin_bit_cast(bf16x8, w_); } while (0)

#define ATT_SOFTMAX(ts_) do { pv0 = v0; pv1 = v1; \
        if (v0) { ATT_BIAS(s0, (ts_) * 64); float mx = s0[0]; \
            _Pragma("unroll") for (int i = 1; i < 16; ++i) mx = fmaxf(mx, s0[i]); \
            if (v1) { ATT_BIAS(s1, (ts_) * 64 + 32); _Pragma("unroll") for (int i = 0; i < 16; ++i) mx = fmaxf(mx, s1[i]); } \
            mx = fmaxf(mx, __shfl_xor(mx, 32)); \
            const float mnew = fmaxf(mrun, mx), alpha = __builtin_amdgcn_exp2f(mrun - mnew); mrun = mnew; \
            float rsum = 0.f; \
            _Pragma("unroll") for (int i = 0; i < 16; ++i) { s0[i] = __builtin_amdgcn_exp2f(s0[i] - mnew); rsum += s0[i]; } \
            if (v1) { _Pragma("unroll") for (int i = 0; i < 16; ++i) { s1[i] = __builtin_amdgcn_exp2f(s1[i] - mnew); rsum += s1[i]; } } \
            lrun = lrun * alpha + rsum; \
            if (__any(alpha != 1.0f)) { _Pragma("unroll") for (int d = 0; d < 4; ++d) _Pragma("unroll") for (int i = 0; i < 16; ++i) o[d][i] *= alpha; } \
            ATT_PACK(pf[0], s0, 0); ATT_PACK(pf[1], s0, 1); \
            if (v1) { ATT_PACK(pf[2], s1, 0); ATT_PACK(pf[3], s1, 1); } \
        } } while (0)

#define ATT_PV(tp_) do { const LAS unsigned char* vp = lds + OFF_V + ((tp_) % NSLOT) * VBUF; \
        if (pv0) { bf16x8 vf[8]; \
            _Pragma("unroll") for (int d = 0; d < 4; ++d) _Pragma("unroll") for (int s = 0; s < 2; ++s) vf[2 * d + s] = *(const LAS bf16x8*)(vp + d * 4096 + voff[s]); \
            __builtin_amdgcn_sched_barrier(0); \
            _Pragma("unroll") for (int d = 0; d < 4; ++d) _Pragma("unroll") for (int s = 0; s < 2; ++s) o[d] = __builtin_amdgcn_mfma_f32_32x32x16_bf16(vf[2 * d + s], pf[s], o[d], 0, 0, 0); \
            __builtin_amdgcn_sched_barrier(0); } \
        if (pv1) { bf16x8 vf[8]; \
            _Pragma("unroll") for (int d = 0; d < 4; ++d) _Pragma("unroll") for (int s = 0; s < 2; ++s) vf[2 * d + s] = *(const LAS bf16x8*)(vp + d * 4096 + voff[2 + s]); \
            __builtin_amdgcn_sched_barrier(0); \
            _Pragma("unroll") for (int d = 0; d < 4; ++d) _Pragma("unroll") for (int s = 0; s < 2; ++s) o[d] = __builtin_amdgcn_mfma_f32_32x32x16_bf16(vf[2 * d + s], pf[2 + s], o[d], 0, 0, 0); \
            __builtin_amdgcn_sched_barrier(0); } \
    } while (0)

    asm volatile("s_waitcnt vmcnt(0) lgkmcnt(0)" ::: "memory"); __builtin_amdgcn_s_barrier(); asm volatile("" ::: "memory");
    for (int t = 0; t <= nt; ++t) {
        if (t + 2 < nt) ATT_DMAK(t + 2);
        if (t + 1 < nt) ATT_DMAV(t + 1);
        if (!lead && t >= 1) ATT_SOFTMAX(t - 1);
        if (t >= 1) ATT_PV(t - 1);
        if (t < nt) ATT_QK(t);
        if (lead && t < nt) ATT_SOFTMAX(t);
        if (t + 2 < nt) asm volatile("s_waitcnt vmcnt(4) lgkmcnt(0)" ::: "memory"); else asm volatile("s_waitcnt vmcnt(0) lgkmcnt(0)" ::: "memory");
        __builtin_amdgcn_s_barrier(); asm volatile("" ::: "memory");
    }
#undef ATT_DMAK
#undef ATT_DMAV
#undef ATT_QK
#undef ATT_BIAS
#undef ATT_PACK
#undef ATT_SOFTMAX
#undef ATT_PV
    lrun += __shfl_xor(lrun, 32);
    const float inv = 1.0f / lrun;
    bf16_t* Op = CAT + (size_t)(b * SEQ + qpos) * DM + hh * HD + 4 * hi;
#pragma unroll
    for (int d = 0; d < 4; ++d)
#pragma unroll
        for (int g = 0; g < 4; ++g) { u32x2 w; w.x = cvtpk(o[d][4 * g] * inv, o[d][4 * g + 1] * inv); w.y = cvtpk(o[d][4 * g + 2] * inv, o[d][4 * g + 3] * inv);
            *(u32x2*)(Op + 32 * d + 8 * g) = w; }
}
}


#define XB_TMO      128
#define XB_XCNT(j)  (256  + 64 * (j))
#define XB_XSUB(j)  (1280 + 64 * (j))
#define XB_XGEN(j)  (2304 + 64 * (j))
#define XB_TOP      3328
#define XB_TOPGEN   3392
#define XCD_BAR_WORDS 3456
#define XB_SPIN_CAP (1u << 18)
__device__ __forceinline__ unsigned xb_ld(unsigned* p)              { return __hip_atomic_load(p, __ATOMIC_RELAXED, __HIP_MEMORY_SCOPE_AGENT); }
__device__ __forceinline__ unsigned xb_add(unsigned* p, unsigned v) { return __hip_atomic_fetch_add(p, v, __ATOMIC_RELAXED, __HIP_MEMORY_SCOPE_AGENT); }
__device__ __forceinline__ unsigned xb_xcc_id() { return (unsigned)__builtin_amdgcn_s_getreg((3 << 11) | 20) & 0xFu; }
#define XB_SPIN(cond, bar) do { unsigned _sp = 0; while (cond) { __builtin_amdgcn_s_sleep(1); \
    if ((++_sp & 255u) == 0u) { if (xb_ld(&(bar)[XB_TMO])) break; if (_sp > XB_SPIN_CAP) { atomicAdd(&(bar)[XB_TMO], 1u); break; } } } } while (0)
struct XcdBarrier { unsigned* bar; unsigned x; volatile LAS unsigned* st; };
__device__ __forceinline__ XcdBarrier xcd_barrier_post(unsigned* bar, volatile LAS unsigned* st) {
    XcdBarrier b; b.bar = bar; b.x = xb_xcc_id(); b.st = st;
    if (threadIdx.x == 0) st[5] = xb_add(&bar[XB_XCNT(b.x)], 1u);
    return b;
}
__device__ __forceinline__ void xcd_barrier_complete(unsigned* bar, unsigned x, unsigned& nloc, unsigned& nx) {
    const unsigned G = gridDim.x * gridDim.y * gridDim.z;
    unsigned sum, cnt, mine, sp = 0u;
    for (;;) {
        sum = 0u; cnt = 0u; mine = 0u;
#pragma unroll
        for (unsigned j = 0; j < 16; ++j) { const unsigned c = xb_ld(&bar[XB_XCNT(j)]); sum += c; cnt += (c > 0u) ? 1u : 0u; mine = (j == x) ? c : mine; }
        if (sum == G) break;
        __builtin_amdgcn_s_sleep(1);
        if ((++sp & 255u) == 0u) { if (xb_ld(&bar[XB_TMO])) break; if (sp > XB_SPIN_CAP) { atomicAdd(&bar[XB_TMO], 1u); break; } }
    }
    nloc = mine > 0u ? mine : 1u; nx = cnt > 0u ? cnt : 1u;
}
__device__ __forceinline__ void xcd_barrier(const XcdBarrier& b) {
    asm volatile("s_waitcnt vmcnt(0)" ::: "memory");
    __syncthreads();
    if (threadIdx.x == 0) {
        unsigned* bar = b.bar;
        __builtin_amdgcn_s_waitcnt(0);
        unsigned nloc = b.st[0], nx = b.st[1];
        if (nloc == 0u) { xcd_barrier_complete(bar, b.x, nloc, nx); b.st[0] = nloc; b.st[1] = nx; }
        const unsigned old = xb_add(&bar[XB_XSUB(b.x)], 1u);
        const unsigned gen = old / nloc;
        if (old + 1u == (gen + 1u) * nloc) {
            __builtin_amdgcn_fence(__ATOMIC_RELEASE, "agent");
            asm volatile("s_waitcnt vmcnt(0)" ::: "memory");
            const unsigned og = xb_add(&bar[XB_TOP], 1u);
            const unsigned tg = og / nx;
            if (og + 1u == (tg + 1u) * nx) xb_add(&bar[XB_TOPGEN], 1u);
            else XB_SPIN(xb_ld(&bar[XB_TOPGEN]) == tg, bar);
            __builtin_amdgcn_fence(__ATOMIC_ACQUIRE, "agent");
            xb_add(&bar[XB_XGEN(b.x)], 1u);
            asm volatile("s_waitcnt vmcnt(0)" ::: "memory");
        } else {
            XB_SPIN(xb_ld(&bar[XB_XGEN(b.x)]) == gen, bar);
            __builtin_amdgcn_fence(__ATOMIC_ACQUIRE, "agent");
            asm volatile("s_waitcnt vmcnt(0)" ::: "memory");
        }
    }
    __syncthreads();
}

constexpr int NWAVES = 8;
constexpr int LDS_BYTES = 147456;

struct Args { const float* in[19]; float* out; unsigned char* ws; };

__device__ __forceinline__ void p0_item(const float* W, int ldw, int col0, int k0, const float* gain, bf16_t* WT, int K, int drow0, LAS float* scr, int lane) {
    float v[64];
    const float* src = W + (size_t)k0 * ldw + col0 + lane;
#pragma unroll
    for (int i = 0; i < 64; ++i) v[i] = src[(size_t)i * ldw];
    const int c = lane & 7;
    f32x4 g0 = {1.f, 1.f, 1.f, 1.f}, g1 = {1.f, 1.f, 1.f, 1.f};
    if (gain) { g0 = *(const f32x4*)(gain + k0 + 8 * c); g1 = *(const f32x4*)(gain + k0 + 8 * c + 4); }
#pragma unroll
    for (int i = 0; i < 64; ++i) scr[i * 65 + lane] = v[i];
    asm volatile("s_waitcnt lgkmcnt(0)" ::: "memory");
#pragma unroll
    for (int j = 0; j < 8; ++j) { const int n = (lane >> 3) + 8 * j; const LAS float* s = scr + (8 * c) * 65 + n;
        u32x4 o; o.x = cvtpk(s[0 * 65] * g0[0], s[1 * 65] * g0[1]); o.y = cvtpk(s[2 * 65] * g0[2], s[3 * 65] * g0[3]); o.z = cvtpk(s[4 * 65] * g1[0], s[5 * 65] * g1[1]); o.w = cvtpk(s[6 * 65] * g1[2], s[7 * 65] * g1[3]);
        *(u32x4*)(WT + (size_t)(drow0 + n) * K + k0 + 8 * c) = o; }
    asm volatile("s_waitcnt lgkmcnt(0)" ::: "memory");
}

__global__ void __launch_bounds__(NWAVES * 64, 2) fwd_megakernel(Args args) {
    extern __shared__ __attribute__((aligned(16))) unsigned char lds_raw[];
    LAS unsigned char* lds = (LAS unsigned char*)lds_raw;
    cg::grid_group grid = cg::this_grid();
    const int tid = threadIdx.x, lane = tid & 63, wave = __builtin_amdgcn_readfirstlane(tid >> 6);
    const int G = gridDim.x, bx = blockIdx.x;
    const int vcu = (G % 8 == 0) ? (bx % 8) * (G / 8) + bx / 8 : bx;
    const int gw = vcu * NWAVES + wave, NGW = G * NWAVES;
    const long gt = (long)bx * (NWAVES * 64) + tid, NGT = (long)G * NWAVES * 64;
    unsigned char* ws = args.ws;
    volatile LAS unsigned* bst = (volatile LAS unsigned*)(lds + LDS_BYTES - 64);
    if (tid < 16) bst[tid] = 0u;
    if (bx == 0) for (int i = tid; i < 4096; i += NWAVES * 64) ((unsigned*)(ws + WS_BAR))[i] = 0u;
    __syncthreads();
    grid.sync();
    const XcdBarrier xbar = xcd_barrier_post((unsigned*)(ws + WS_BAR), bst);
    const float* x = args.in[0];
    float* out = args.out;
    float* ss = (float*)(ws + WS_SS);
    float* logfb = (float*)(ws + WS_LOGF);
    float* wf = (float*)(ws + WS_WF);
    bf16_t* W1 = (bf16_t*)(ws + WS_W1); bf16_t* WD1 = (bf16_t*)(ws + WS_WD1); bf16_t* VT = (bf16_t*)(ws + WS_VT);
    bf16_t* WQK = (bf16_t*)(ws + WS_WQK); bf16_t* WV = (bf16_t*)(ws + WS_WV); bf16_t* WO = (bf16_t*)(ws + WS_WO);
    bf16_t* W2 = (bf16_t*)(ws + WS_W2); bf16_t* WD2 = (bf16_t*)(ws + WS_WD2); bf16_t* WPG = (bf16_t*)(ws + WS_WPG); bf16_t* WPP = (bf16_t*)(ws + WS_WPP);
    bf16_t* PB = (bf16_t*)(ws + WS_PB); bf16_t* XB = (bf16_t*)(ws + WS_XB); bf16_t* HB = (bf16_t*)(ws + WS_H); bf16_t* QKB = (bf16_t*)(ws + WS_QK); bf16_t* CAT = (bf16_t*)(ws + WS_CAT);

    {
        LAS float* scr = (LAS float*)(lds + wave * 16640);
        constexpr int I_GU = (DM / 64) * (FF / 64), I_DN = (FF / 64) * (DM / 64), I_IN = (DM / 64) * (1024 / 64), I_SQ = (DM / 64) * (DM / 64), I_PP = (PLE / 64) * (DM / 64);
        constexpr int NITEMS = 4 * I_GU + 2 * I_DN + 6 * I_IN + 2 * I_SQ + I_PP;
        for (int it = gw; it < NITEMS; it += NGW) {
            int r = it;
#define SEG_GU(Wsrc, gainp, dst, half) if (r < I_GU) { const int nblk = FF / 64, kb = r / nblk, nb = r % nblk, n0 = 64 * nb; \
                p0_item(Wsrc, FF, n0, 64 * kb, gainp, dst, DM, (n0 / 128) * 256 + (n0 % 128) + (half) * 128, scr, lane); continue; } r -= I_GU;
#define SEG_ID(Wsrc, ldw, colbase, Kdim, ncols, gainp, dst, drow, cnt) if (r < (cnt)) { const int nblk = (ncols) / 64, kb = r / nblk, nb = r % nblk; \
                p0_item(Wsrc, ldw, (colbase) + 64 * nb, 64 * kb, gainp, dst, Kdim, (drow) + 64 * nb, scr, lane); continue; } r -= (cnt);
            SEG_GU(args.in[3], args.in[2], W1, 0)
            SEG_GU(args.in[4], args.in[2], W1, 1)
            SEG_ID(args.in[5], DM, 0, FF, DM, (const float*)nullptr, WD1, 0, I_DN)
            SEG_ID(args.in[7], DIN, 0, DM, 1024, args.in[6], WQK, 0, I_IN)
            SEG_ID(args.in[7], DIN, 1024, DM, 1024, args.in[6], WQK, 1024, I_IN)
            SEG_ID(args.in[7], DIN, 2048, DM, 1024, args.in[6], WV, 0, I_IN)
            SEG_ID(args.in[7], DIN, 3080, DM, 1024, args.in[6], WQK, 2048, I_IN)
            SEG_ID(args.in[7], DIN, 4104, DM, 1024, args.in[6], WQK, 3072, I_IN)
            SEG_ID(args.in[7], DIN, 5128, DM, 1024, args.in[6], WV, 1024, I_IN)
            SEG_ID(args.in[9], DM, 0, DM, DM, (const float*)nullptr, WO, 0, I_SQ)
            SEG_GU(args.in[11], args.in[10], W2, 0)
            SEG_GU(args.in[12], args.in[10], W2, 1)
            SEG_ID(args.in[13], DM, 0, FF, DM, (const float*)nullptr, WD2, 0, I_DN)
            SEG_ID(args.in[15], DM, 0, DM, DM, args.in[14], WPG, 0, I_SQ)
            SEG_ID(args.in[16], DM, 0, PLE, DM, (const float*)nullptr, WPP, 0, I_PP)
#undef SEG_GU
#undef SEG_ID
        }
        for (int m0 = gw * 4; m0 < M; m0 += NGW * 4) {
            f32x4 v[4][8];
#pragma unroll
            for (int q = 0; q < 4; ++q) { const f32x4* xr = (const f32x4*)(x + (size_t)(m0 + q) * DM) + lane;
#pragma unroll
                for (int j = 0; j < 8; ++j) v[q][j] = xr[64 * j]; }
#pragma unroll
            for (int q = 0; q < 4; ++q) { float sq = 0.f;
#pragma unroll
                for (int j = 0; j < 8; ++j) sq += (v[q][j][0] * v[q][j][0] + v[q][j][1] * v[q][j][1]) + (v[q][j][2] * v[q][j][2] + v[q][j][3] * v[q][j][3]);
                sq = wave_sum(sq); if (lane == 0) ss[m0 + q] = sq;
                u32x2* o8 = (u32x2*)(XB + (size_t)(m0 + q) * DM) + lane;
#pragma unroll
                for (int j = 0; j < 8; ++j) { u32x2 w; w.x = cvtpk(v[q][j][0], v[q][j][1]); w.y = cvtpk(v[q][j][2], v[q][j][3]); o8[64 * j] = w; } }
        }
        { const f32x4* p4 = (const f32x4*)args.in[1]; u32x2* o8 = (u32x2*)PB;
          for (long i = gt; i < (long)M * PLE / 4; i += 4 * NGT) {
              f32x4 v[4];
#pragma unroll
              for (int q = 0; q < 4; ++q) if (i + q * NGT < (long)M * PLE / 4) v[q] = p4[i + q * NGT];
#pragma unroll
              for (int q = 0; q < 4; ++q) if (i + q * NGT < (long)M * PLE / 4) { u32x2 w; w.x = cvtpk(v[q][0], v[q][1]); w.y = cvtpk(v[q][2], v[q][3]); o8[i + q * NGT] = w; } } }
        for (long i = gt; i < 4L * M; i += NGT) ss[M + i] = 0.f;
        for (long i = gt; i < (long)NH * DM; i += NGT) { const int h = (int)(i / DM), k = (int)(i % DM); wf[i] = args.in[6][k] * args.in[7][(size_t)k * DIN + 3072 + h]; }
    }
    xcd_barrier(xbar);
    if (tid == 0) { unsigned* barw = (unsigned*)(ws + WS_BAR); bool bal = (G % 8 == 0);
        for (unsigned jx = 0; jx < 16; ++jx) { const unsigned cnt = xb_ld(&barw[XB_XCNT(jx)]); bal = bal && (cnt == (jx < 8 ? (unsigned)(G / 8) : 0u)); }
        bst[7] = bal ? bst[5] * 8u + xbar.x : (unsigned)bx; }
    __syncthreads();
    const int vc = __builtin_amdgcn_readfirstlane((int)bst[7]);
    const int vcu2 = (G % 8 == 0) ? (vc % 8) * (G / 8) + vc / 8 : vc;

#pragma unroll 1
    for (int j = 0; j < 9; ++j) {
        if (j == 2) {
            const int ln = opaque_tid() & 63;
            float wreg[32];
#pragma unroll
            for (int jj = 0; jj < 4; ++jj) { const f32x4 a = *(const f32x4*)(wf + (size_t)wave * DM + 512 * jj + 8 * ln), bq = *(const f32x4*)(wf + (size_t)wave * DM + 512 * jj + 8 * ln + 4);
#pragma unroll
                for (int e = 0; e < 4; ++e) { wreg[8 * jj + e] = a[e]; wreg[8 * jj + 4 + e] = bq[e]; } }
            const float bf = args.in[8][wave];
            for (int m0 = vcu2 * 4; m0 < M; m0 += G * 4) {
                u32x4 pw[4][4]; float sq[4];
#pragma unroll
                for (int q = 0; q < 4; ++q) { sq[q] = ss[M + m0 + q];
#pragma unroll
                    for (int jj = 0; jj < 4; ++jj) pw[q][jj] = *(const u32x4*)(XB + (size_t)(m0 + q) * DM + 512 * jj + 8 * ln); }
#pragma unroll
                for (int q = 0; q < 4; ++q) { float d = 0.f;
#pragma unroll
                    for (int jj = 0; jj < 4; ++jj) { const u32x4 w = pw[q][jj];
                        d += __uint_as_float(w.x << 16) * wreg[8 * jj + 0] + __uint_as_float(w.x & 0xffff0000u) * wreg[8 * jj + 1] + __uint_as_float(w.y << 16) * wreg[8 * jj + 2] + __uint_as_float(w.y & 0xffff0000u) * wreg[8 * jj + 3]
                           + __uint_as_float(w.z << 16) * wreg[8 * jj + 4] + __uint_as_float(w.z & 0xffff0000u) * wreg[8 * jj + 5] + __uint_as_float(w.w << 16) * wreg[8 * jj + 6] + __uint_as_float(w.w & 0xffff0000u) * wreg[8 * jj + 7]; }
                    d = wave_sum(d);
                    if (ln == 0) { const int m = m0 + q; const float f = d * rs_from_ss(sq[q]) + bf; const float lf = fminf(f, 0.f) - log1pf(__expf(-fabsf(f)));
                        logfb[((size_t)(m / SEQ) * NH + wave) * SEQ + (m % SEQ)] = lf; } }
            }
        }
        if (j == 4) {
            for (int g = vcu2; g < 256; g += G) {
                const int b = (g >> 1) >> 4, hh = (g >> 1) & 15, j0 = 2 * (g & 1);
                att::build_table(lds, b, hh, logfb, args.in[17]);
                att::attn_unit(lds, b, hh, 7 - j0, QKB, VT, CAT);
                att::attn_unit(lds, b, hh, 6 - j0, QKB, VT, CAT);
                att::attn_unit(lds, b, hh, j0 + 1, QKB, VT, CAT);
                att::attn_unit(lds, b, hh, j0, QKB, VT, CAT);
            }
            xcd_barrier(xbar);
        }
        pg8::Gemm g; pg8::Epi E; E.ss_in = nullptr; E.base = nullptr; E.of = nullptr; E.ss_out = nullptr; E.proj = nullptr; E.xb_in = nullptr; E.alpha = 0.f; E.ob = nullptr; E.ldc = 0; E.mode = 0;
        switch (j) {
            case 0: g = pg8::Gemm{XB, W1, M, 2 * FF, DM}; E.mode = pg8::EPI_SWIGLU; E.ob = HB; E.ldc = FF; E.ss_in = ss; break;
            case 1: g = pg8::Gemm{HB, WD1, M, DM, FF}; E.mode = pg8::EPI_RESID; E.xb_in = XB; E.ob = XB; E.ss_out = ss + M; E.alpha = 0.5f; break;
            case 2: g = pg8::Gemm{XB, WQK, M, NQK, DM}; E.mode = pg8::EPI_BF16; E.ob = QKB; E.ldc = 0; E.ss_in = ss + M; break;
            case 3: g = pg8::Gemm{WV, XB, NVT, M, DM}; E.mode = pg8::EPI_COLSCALE; E.ob = VT; E.ldc = M; E.ss_in = ss + M; break;
            case 4: g = pg8::Gemm{CAT, WO, M, DM, DM}; E.mode = pg8::EPI_RESID; E.xb_in = XB; E.ob = XB; E.ss_out = ss + 2 * M; E.alpha = 1.0f; break;
            case 5: g = pg8::Gemm{XB, W2, M, 2 * FF, DM}; E.mode = pg8::EPI_SWIGLU; E.ob = HB; E.ldc = FF; E.ss_in = ss + 2 * M; break;
            case 6: g = pg8::Gemm{PB, WPP, M, DM, PLE}; E.mode = pg8::EPI_BF16; E.ob = CAT; E.ldc = DM; break;
            case 7: g = pg8::Gemm{HB, WD2, M, DM, FF}; E.mode = pg8::EPI_RESID; E.xb_in = XB; E.ob = XB; E.ss_out = ss + 3 * M; E.alpha = 0.5f; break;
            default: g = pg8::Gemm{XB, WPG, M, DM, DM}; E.mode = pg8::EPI_PLE; E.xb_in = XB; E.ob = HB; E.ss_in = ss + 3 * M; E.ss_out = ss + 4 * M; E.proj = CAT; break;
        }
        pg8::StaticOrder S; S.init(g.M, g.N, G, vc, g.M == NVT ? 8 : pg8::WGM);
        pg8::gemm_phase(lds, g, S, E);
        if (j != 2 && j != 6) xcd_barrier(xbar);
    }

    {
        const float* gf = args.in[18];
        for (int m0 = gw * 8; m0 < M; m0 += NGW * 8) {
            u32x2 w[8][8]; float r[8];
#pragma unroll
            for (int q = 0; q < 8; ++q) { const u32x2* xr = (const u32x2*)(HB + (size_t)(m0 + q) * DM) + lane; r[q] = ss[4 * M + m0 + q];
#pragma unroll
                for (int jj = 0; jj < 8; ++jj) w[q][jj] = xr[64 * jj]; }
            const f32x4* g4 = (const f32x4*)gf + lane;
#pragma unroll
            for (int q = 0; q < 8; ++q) { f32x4* orow = (f32x4*)(out + (size_t)(m0 + q) * DM) + lane; const float rq = rs_from_ss(r[q]);
#pragma unroll
                for (int jj = 0; jj < 8; ++jj) { const f32x4 gg = g4[64 * jj]; f32x4 v;
                    v[0] = __uint_as_float(w[q][jj].x << 16); v[1] = __uint_as_float(w[q][jj].x & 0xffff0000u); v[2] = __uint_as_float(w[q][jj].y << 16); v[3] = __uint_as_float(w[q][jj].y & 0xffff0000u);
                    orow[64 * jj] = v * rq * gg; } }
        }
    }
}

extern "C" void kernel_launch(void* const* d_in, const int* in_sizes, int n_in, void* d_out, int out_size, void* d_ws, size_t ws_size, hipStream_t stream) {
    static int grid = 0;
    if (grid == 0) {
        if (n_in != 19 || out_size != M * DM || ws_size < WS_END) { fprintf(stderr, "kernel_launch: unexpected problem (n_in %d, out %d, ws %zu)\n", n_in, out_size, ws_size); grid = -1; return; }
        int dev = 0, cus = 0, per_cu = 0;
        hipGetDevice(&dev);
        hipDeviceGetAttribute(&cus, hipDeviceAttributeMultiprocessorCount, dev);
        hipFuncSetAttribute((const void*)fwd_megakernel, hipFuncAttributeMaxDynamicSharedMemorySize, LDS_BYTES);
        hipOccupancyMaxActiveBlocksPerMultiprocessor(&per_cu, (const void*)fwd_megakernel, NWAVES * 64, LDS_BYTES);
        if (per_cu < 1) { fprintf(stderr, "kernel_launch: occupancy query says %d blocks per CU\n", per_cu); per_cu = 1; }
        (void)hipGetLastError();
        grid = cus * 1;
    }
    if (grid < 0) return;
    Args a{};
    for (int i = 0; i < 19; ++i) a.in[i] = (const float*)d_in[i];
    a.out = (float*)d_out; a.ws = (unsigned char*)d_ws;
    void* kargs[] = {&a};
    hipError_t e = hipLaunchCooperativeKernel((const void*)fwd_megakernel, dim3(grid), dim3(NWAVES * 64), kargs, LDS_BYTES, stream);
    if (e != hipSuccess) fprintf(stderr, "cooperative launch failed: %s (grid %d)\n", hipGetErrorString(e), grid);
}
```
